# Optimizing an MI355X kernel written in HIP

```python
import math
import jax, jax.numpy as jnp
from jax import lax
import numpy as np

D_MODEL = 1024
BATCH = 4
SEQ = 8192
DEPTH = 1

MEM_LEN = 256

SB_HEADS = 8
SB_HEAD_DIM = D_MODEL // 16
SB_WIDTH = SB_HEADS * SB_HEAD_DIM
SB_BLOCK = 128

RET_HEADS = 4
RET_QK_DIM = D_MODEL // 8
RET_V_DIM = 2 * RET_QK_DIM
RET_QK_WIDTH = RET_HEADS * RET_QK_DIM
RET_V_WIDTH = RET_HEADS * RET_V_DIM
RET_CHUNK = 128
ROPE_BASE = 10000.0

N_BRANCHES = 2

OFF_SB_Q = 0
OFF_SB_K = OFF_SB_Q + SB_WIDTH
OFF_SB_V = OFF_SB_K + SB_WIDTH
OFF_RET_Q = OFF_SB_V + SB_WIDTH
OFF_RET_K = OFF_RET_Q + RET_QK_WIDTH
OFF_RET_V = OFF_RET_K + RET_QK_WIDTH
OFF_RET_G = OFF_RET_V + RET_V_WIDTH
OFF_GATE = OFF_RET_G + RET_V_WIDTH
IN_WIDTH = OFF_GATE + N_BRANCHES * D_MODEL

MEM_HEADS = 4
MEM_HEAD_DIM = D_MODEL // MEM_HEADS

FFN_HIDDEN = -(-8 * D_MODEL // (3 * 256)) * 256

DN_ALPHA = (2.0 * DEPTH) ** 0.25
DN_BETA = (8.0 * DEPTH) ** -0.25
LN_EPS = 1e-5

kernel_name = "hybrid_stickbreak_retention_deepnorm"


def layer_norm(x, g, b):
    xf = x.astype(jnp.float32)
    mu = jnp.mean(xf, -1, keepdims=True)
    var = jnp.mean(jnp.square(xf - mu), -1, keepdims=True)
    return ((xf - mu) * lax.rsqrt(var + LN_EPS)).astype(x.dtype) * g + b


def head_norm(x):
    xf = x.astype(jnp.float32)
    mu = jnp.mean(xf, -1, keepdims=True)
    var = jnp.mean(jnp.square(xf - mu), -1, keepdims=True)
    return (xf - mu) * lax.rsqrt(var + LN_EPS)


def rotary(x):
    S, d = x.shape[1], x.shape[-1]
    half = d // 2
    inv = 1.0 / (ROPE_BASE ** (jnp.arange(half, dtype=jnp.float32) / half))
    ang = jnp.arange(S, dtype=jnp.float32)[:, None] * inv[None, :]
    cos = jnp.cos(ang)[None, :, None, :]
    sin = jnp.sin(ang)[None, :, None, :]
    xf = x.astype(jnp.float32)
    x1, x2 = xf[..., :half], xf[..., half:]
    return jnp.concatenate([x1 * cos - x2 * sin, x1 * sin + x2 * cos], -1).astype(x.dtype)


def stick_breaking_attention(q, k, v):
    B, S, H, d = q.shape
    nb = S // SB_BLOCK
    qb = (q.astype(jnp.float32) * (d ** -0.5)).reshape(B, nb, SB_BLOCK, H, d).transpose(1, 0, 3, 2, 4)
    kf = k.astype(jnp.float32).transpose(0, 2, 1, 3)
    vf = v.astype(jnp.float32).transpose(0, 2, 1, 3)
    key_pos = jnp.arange(S)

    def one_block(args):
        q_blk, blk = args
        q_pos = blk * SB_BLOCK + jnp.arange(SB_BLOCK)
        mask = key_pos[None, :] < q_pos[:, None]
        z = jnp.einsum('bhqd,bhkd->bhqk', q_blk, kf)
        log_beta = jax.nn.log_sigmoid(z)
        log_rem = jnp.where(mask, jax.nn.log_sigmoid(-z), 0.0)
        later = lax.cumsum(log_rem, axis=3, reverse=True) - log_rem
        w = jnp.where(mask, jnp.exp(log_beta + later), 0.0)
        return jnp.einsum('bhqk,bhkd->bhqd', w, vf)

    out = lax.map(one_block, (qb, jnp.arange(nb)))
    return out.transpose(1, 0, 3, 2, 4).reshape(B, S, H * d)


def retention(q, k, v):
    B, S, H, dk = q.shape
    dv = v.shape[-1]
    nc = S // RET_CHUNK
    log_gamma = jnp.log1p(-jnp.exp2(-5.0 - jnp.arange(H, dtype=jnp.float32)))
    qc = (q.astype(jnp.float32) * (dk ** -0.5)).reshape(B, nc, RET_CHUNK, H, dk)
    kc = k.astype(jnp.float32).reshape(B, nc, RET_CHUNK, H, dk)
    vc = v.astype(jnp.float32).reshape(B, nc, RET_CHUNK, H, dv)
    idx = jnp.arange(RET_CHUNK, dtype=jnp.float32)
    rel = idx[:, None] - idx[None, :]
    decay = jnp.where(rel[None] >= 0,
                      jnp.exp(log_gamma[:, None, None] * jnp.maximum(rel, 0.0)[None]), 0.0)
    scores = jnp.einsum('bnihd,bnjhd->bnhij', qc, kc) * decay
    inner = jnp.einsum('bnhij,bnjhe->bnihe', scores, vc)
    k_decay = jnp.exp(log_gamma[None, :] * (RET_CHUNK - 1.0 - idx)[:, None])
    chunk_kv = jnp.einsum('bnjhd,jh,bnjhe->nbhde', kc, k_decay, vc)
    chunk_decay = jnp.exp(log_gamma * RET_CHUNK)[None, :, None, None]

    def step(state, kv):
        return state * chunk_decay + kv, state

    _, states = lax.scan(step, jnp.zeros((B, H, dk, dv), jnp.float32), chunk_kv)
    q_decay = jnp.exp(log_gamma[None, :] * (idx + 1.0)[:, None])
    cross = jnp.einsum('bnihd,ih,nbhde->bnihe', qc, q_decay, states)
    return (inner + cross).reshape(B, S, H, dv)


def memory_cross_attention(x, mem, w_q, w_kv, w_o):
    B, S, _ = x.shape
    q = (x @ w_q).reshape(B, S, MEM_HEADS, MEM_HEAD_DIM)
    kv = (mem @ w_kv).reshape(B, MEM_LEN, 2, MEM_HEADS, MEM_HEAD_DIM)
    k, v = kv[:, :, 0], kv[:, :, 1]
    s = jnp.einsum('bshd,bmhd->bhsm', q.astype(jnp.float32), k.astype(jnp.float32)) * (MEM_HEAD_DIM ** -0.5)
    p = jax.nn.softmax(s, axis=-1)
    o = jnp.einsum('bhsm,bmhd->bshd', p, v.astype(jnp.float32)).reshape(B, S, D_MODEL)
    return o.astype(x.dtype) @ w_o


def setup_inputs(seed: int = 0) -> dict:
    key = jax.random.key(seed)
    ks = jax.random.split(key, 24)
    nrm = lambda k, shape: jax.random.normal(k, shape, jnp.float32)

    def dense(k, fan_in, fan_out, scale=1.0):
        return nrm(k, (DEPTH, fan_in, fan_out)) * (fan_in ** -0.5) * scale

    gain = lambda k: 1.0 + 0.02 * nrm(k, (DEPTH, D_MODEL))
    bias = lambda k, n: 0.02 * nrm(k, (DEPTH, n))

    col_scale = jnp.concatenate([
        jnp.ones((OFF_SB_V,), jnp.float32),
        jnp.full((SB_WIDTH,), DN_BETA, jnp.float32),
        jnp.ones((2 * RET_QK_WIDTH,), jnp.float32),
        jnp.full((RET_V_WIDTH,), DN_BETA, jnp.float32),
        jnp.ones((RET_V_WIDTH + N_BRANCHES * D_MODEL,), jnp.float32)])
    mem_kv_scale = jnp.concatenate([jnp.ones((D_MODEL,), jnp.float32),
                                    jnp.full((D_MODEL,), DN_BETA, jnp.float32)])
    return {
        "x": nrm(ks[0], (BATCH, SEQ, D_MODEL)),
        "mem": nrm(ks[1], (BATCH, MEM_LEN, D_MODEL)),
        "w_in": dense(ks[2], D_MODEL, IN_WIDTH) * col_scale,
        "b_gate": bias(ks[3], N_BRANCHES * D_MODEL),
        "w_sb_o": dense(ks[4], SB_WIDTH, D_MODEL),
        "w_ret_o": dense(ks[5], RET_V_WIDTH, D_MODEL),
        "w_mix_o": dense(ks[6], D_MODEL, D_MODEL, DN_BETA),
        "ln1_g": gain(ks[7]),
        "ln1_b": bias(ks[8], D_MODEL),
        "w_mem_q": dense(ks[9], D_MODEL, D_MODEL),
        "w_mem_kv": dense(ks[10], D_MODEL, 2 * D_MODEL) * mem_kv_scale,
        "w_mem_o": dense(ks[11], D_MODEL, D_MODEL, DN_BETA),
        "ln2_g": gain(ks[12]),
        "ln2_b": bias(ks[13], D_MODEL),
        "w_ffn_in": dense(ks[14], D_MODEL, 2 * FFN_HIDDEN, DN_BETA),
        "w_ffn_out": dense(ks[15], FFN_HIDDEN, D_MODEL, DN_BETA),
        "ln3_g": gain(ks[16]),
        "ln3_b": bias(ks[17], D_MODEL),
    }


def reference(x, mem, w_in, b_gate, w_sb_o, w_ret_o, w_mix_o, ln1_g, ln1_b,
              w_mem_q, w_mem_kv, w_mem_o, ln2_g, ln2_b, w_ffn_in, w_ffn_out, ln3_g, ln3_b):
    B, S, _ = x.shape
    for l in range(DEPTH):
        h = x @ w_in[l]
        sb_q = h[..., OFF_SB_Q:OFF_SB_K].reshape(B, S, SB_HEADS, SB_HEAD_DIM)
        sb_k = h[..., OFF_SB_K:OFF_SB_V].reshape(B, S, SB_HEADS, SB_HEAD_DIM)
        sb_v = h[..., OFF_SB_V:OFF_RET_Q].reshape(B, S, SB_HEADS, SB_HEAD_DIM)
        r_q = rotary(h[..., OFF_RET_Q:OFF_RET_K].reshape(B, S, RET_HEADS, RET_QK_DIM))
        r_k = rotary(h[..., OFF_RET_K:OFF_RET_V].reshape(B, S, RET_HEADS, RET_QK_DIM))
        r_v = h[..., OFF_RET_V:OFF_RET_G].reshape(B, S, RET_HEADS, RET_V_DIM)
        r_g = h[..., OFF_RET_G:OFF_GATE]
        gates = jax.nn.sigmoid(h[..., OFF_GATE:] + b_gate[l]).reshape(B, S, N_BRANCHES, D_MODEL)

        y_sb = stick_breaking_attention(sb_q, sb_k, sb_v).astype(x.dtype) @ w_sb_o[l]
        ret = head_norm(retention(r_q, r_k, r_v)).reshape(B, S, RET_V_WIDTH)
        y_ret = (jax.nn.silu(r_g) * ret.astype(x.dtype)) @ w_ret_o[l]
        mix = (gates[:, :, 0] * y_sb + gates[:, :, 1] * y_ret) @ w_mix_o[l]
        x = layer_norm(DN_ALPHA * x + mix, ln1_g[l], ln1_b[l])

        xa = memory_cross_attention(x, mem, w_mem_q[l], w_mem_kv[l], w_mem_o[l])
        x = layer_norm(DN_ALPHA * x + xa, ln2_g[l], ln2_b[l])

        f = x @ w_ffn_in[l]
        ff = (jax.nn.silu(f[..., :FFN_HIDDEN]) * f[..., FFN_HIDDEN:]) @ w_ffn_out[l]
        x = layer_norm(DN_ALPHA * x + ff, ln3_g[l], ln3_b[l])
    return x
```

```cpp
#include <hip/hip_cooperative_groups.h>
#include <hip/hip_runtime.h>
#include <cstdio>
#include <cstdint>
namespace pg8 {
#define PG8_LAS __attribute__((address_space(3)))
typedef unsigned short bf16_t;
typedef short bf16x8 __attribute__((ext_vector_type(8)));
typedef float f32x4 __attribute__((ext_vector_type(4)));
typedef unsigned u32x4 __attribute__((ext_vector_type(4)));
constexpr int BM = 256, BK = 64, HALF = 128, HTB = HALF * BK * 2  , STAGE_BYTES = 8 * HTB, NXCD = 8, WGM = 8;

__host__ __device__ __forceinline__ int lds_byte(int r, int c) { const int st = (r >> 4) * 2 + (c >> 5), rr = r & 15, cc = c & 31, ob = rr * 64 + cc * 2; return st * 1024 + (ob ^ (((ob >> 9) & 1) << 5)); }
__host__ __device__ __forceinline__ void stage_rc(int b, int& R, int& C) { const int st = b / 1024, sb = b % 1024, swz = sb ^ (((sb >> 9) & 1) << 5); R = (st >> 1) * 16 + swz / 64; C = (st & 1) * 32 + (swz % 64) / 2; }
__host__ __device__ __forceinline__ int perm32(int rho) { const int n = rho >> 4, i = rho & 15; return 8 * (i >> 2) + 4 * n + (i & 3); }

struct Unit { int pm, pn; };
struct Gemm { const bf16_t* A; const bf16_t* Bt; int M, N, K; };

struct StaticOrder {
    int nM, nN, nwg, G, c;
    __host__ __device__ void init(int M, int N, int G_, int c_) { nM = M / BM; nN = N / BM; nwg = nM * nN; G = G_; c = c_; }
    __host__ __device__ bool next(int i, Unit& u) const {
        const long L = (long)i * G + c; if (L >= nwg) return false;
        int wgid = (int)L; { const int q = nwg / NXCD, r = nwg % NXCD, xcd = wgid % NXCD, off = wgid / NXCD; wgid = (xcd < r ? xcd * (q + 1) : r * (q + 1) + (xcd - r) * q) + off; }
        const int nig = WGM * nN, gid = wgid / nig, fm = gid * WGM, gsz = (nM - fm) < WGM ? (nM - fm) : WGM;
        u.pm = fm + ((wgid % nig) % gsz); u.pn = (wgid % nig) / gsz; return true;
    }
    __device__ __forceinline__ void a_ready(const Unit&) const {}
    __device__ __forceinline__ void done(const Unit&) const {}
};

__device__ __forceinline__ unsigned cvt_pk_bf16(float lo, float hi) { unsigned r; asm volatile("v_cvt_pk_bf16_f32 %0, %1, %2" : "=v"(r) : "v"(lo), "v"(hi)); return r; }
typedef float f32x2 __attribute__((ext_vector_type(2)));
__device__ __forceinline__ float ex2(float x) { return __builtin_amdgcn_exp2f(x); }
__device__ __forceinline__ float fexp(float x) { return __builtin_amdgcn_exp2f(x * 1.4426950408889634f); }
__device__ __forceinline__ float sigm(float x) { return __builtin_amdgcn_rcpf(1.f + fexp(-x)); }
__device__ __forceinline__ float silu1(float x) { return x * sigm(x); }
__device__ __forceinline__ f32x4 silu4(f32x4 v) { return (f32x4){silu1(v[0]), silu1(v[1]), silu1(v[2]), silu1(v[3])}; }
__device__ __forceinline__ f32x4 sigm4(f32x4 v) { return (f32x4){sigm(v[0]), sigm(v[1]), sigm(v[2]), sigm(v[3])}; }
__device__ __forceinline__ u32x4 pack8(f32x4 a, f32x4 b) { u32x4 w; w.x = cvt_pk_bf16(a[0], a[1]); w.y = cvt_pk_bf16(a[2], a[3]); w.z = cvt_pk_bf16(b[0], b[1]); w.w = cvt_pk_bf16(b[2], b[3]); return w; }
__device__ __forceinline__ f32x4 unlo(u32x4 w) { return (f32x4){__uint_as_float(w.x << 16), __uint_as_float(w.x & 0xffff0000u), __uint_as_float(w.y << 16), __uint_as_float(w.y & 0xffff0000u)}; }
__device__ __forceinline__ f32x4 unhi(u32x4 w) { return (f32x4){__uint_as_float(w.z << 16), __uint_as_float(w.z & 0xffff0000u), __uint_as_float(w.w << 16), __uint_as_float(w.w & 0xffff0000u)}; }

typedef unsigned u32x2v __attribute__((ext_vector_type(2)));
enum { EPI_PLAIN = 0, EPI_ROT = 1, EPI_ROTT = 2, EPI_SILU = 3, EPI_SWIGLU = 4, EPI_GATEMIX = 5, EPI_RES = 6 };
struct EpiArgs {
    bf16_t* O; bf16_t* O2; int ldc; int split_pn; float scale0, scale1;
    const float* f0; const float* f1;
    const bf16_t* h0; const bf16_t* h1;
    float* Of;
};
constexpr int TOKS = 32768, SEQL = 8192;
constexpr float DN_ALPHA_F = 1.189207115002721f;

template <int MODE> struct Epi {
    static constexpr bool PERM = true, AFTER_DRAIN = false;
    EpiArgs a;
    __device__ __forceinline__ void operator()(const f32x4 (&acc)[2][2][4][2], const Unit& u, int wr, int wc, int fr, int fq) const {
        const int row0 = u.pm * BM + wr * 64 + fr;
        if constexpr (MODE == EPI_PLAIN || MODE == EPI_SILU) {
            int pn = u.pn; bf16_t* base = a.O; float sc = a.scale0;
            if (a.split_pn > 0 && pn >= a.split_pn) { pn -= a.split_pn; base = a.O2; sc = a.scale1; }
            const int col0 = pn * BM + wc * 32 + 8 * fq;
#pragma unroll
            for (int ai = 0; ai < 2; ++ai)
#pragma unroll
                for (int m = 0; m < 4; ++m) { bf16_t* rowp = base + (size_t)(row0 + ai * HALF + m * 16) * a.ldc + col0;
#pragma unroll
                    for (int bj = 0; bj < 2; ++bj) { f32x4 v0 = acc[ai][bj][m][0], v1 = acc[ai][bj][m][1];
                        if constexpr (MODE == EPI_SILU) { v0 = silu4(v0); v1 = silu4(v1); } else { v0 = v0 * sc; v1 = v1 * sc; }
                        *(u32x4*)(rowp + bj * HALF) = pack8(v0, v1); } }
        } else if constexpr (MODE == EPI_ROT) {
            int pn = u.pn; bf16_t* base = a.O; float sc = a.scale0;
            if (pn >= 2) { pn -= 2; base = a.O2; sc = a.scale1; }
            const int head = 2 * pn + (wc >> 1), i0 = 32 * (wc & 1) + 8 * fq, ocol = head * 128 + i0;
#pragma unroll
            for (int ai = 0; ai < 2; ++ai)
#pragma unroll
                for (int m = 0; m < 4; ++m) { const int row = row0 + ai * HALF + m * 16, pos = row & (SEQL - 1);
                    const f32x4 c0 = *(const f32x4*)(a.f0 + pos * 64 + i0), c1 = *(const f32x4*)(a.f0 + pos * 64 + i0 + 4);
                    const f32x4 s0 = *(const f32x4*)(a.f1 + pos * 64 + i0), s1 = *(const f32x4*)(a.f1 + pos * 64 + i0 + 4);
                    const f32x4 x1a = acc[ai][0][m][0], x1b = acc[ai][0][m][1], x2a = acc[ai][1][m][0], x2b = acc[ai][1][m][1];
                    const f32x4 o1a = (x1a * c0 - x2a * s0) * sc, o1b = (x1b * c1 - x2b * s1) * sc, o2a = (x1a * s0 + x2a * c0) * sc, o2b = (x1b * s1 + x2b * c1) * sc;
                    bf16_t* rowp = base + (size_t)row * 512 + ocol;
                    *(u32x4*)(rowp) = pack8(o1a, o1b); *(u32x4*)(rowp + 64) = pack8(o2a, o2b); }
        } else if constexpr (MODE == EPI_ROTT) {
            const unsigned tokb = (unsigned)(u.pn * BM + wc * 32 + 8 * fq);
            const unsigned tb = (unsigned)fr * SEQL + (tokb & (SEQL - 1));
            const unsigned ob = (unsigned)((2 * u.pm + wr) * 128 + fr) * (unsigned)a.ldc + tokb;
#pragma unroll
            for (int m = 0; m < 4; ++m)
#pragma unroll
                for (int bj = 0; bj < 2; ++bj)
#pragma unroll
                    for (int n = 0; n < 2; ++n) { const unsigned to = tb + (unsigned)(m * 16 * SEQL + bj * HALF + n * 4);
                        const f32x4 c0 = *(const f32x4*)(a.f0 + to), s0 = *(const f32x4*)(a.f1 + to);
                        const f32x4 x1 = acc[0][bj][m][n], x2 = acc[1][bj][m][n];
                        const f32x4 o1 = x1 * c0 - x2 * s0, o2 = x1 * s0 + x2 * c0;
                        const unsigned oo = ob + (unsigned)(m * 16) * (unsigned)a.ldc + (unsigned)(bj * HALF + n * 4);
                        u32x2v w1, w2; w1.x = cvt_pk_bf16(o1[0], o1[1]); w1.y = cvt_pk_bf16(o1[2], o1[3]); w2.x = cvt_pk_bf16(o2[0], o2[1]); w2.y = cvt_pk_bf16(o2[2], o2[3]);
                        *(u32x2v*)(a.O + oo) = w1; *(u32x2v*)(a.O + oo + 64u * (unsigned)a.ldc) = w2; }
        } else if constexpr (MODE == EPI_SWIGLU) {
            const int col0 = u.pn * 128 + wc * 32 + 8 * fq;
#pragma unroll
            for (int ai = 0; ai < 2; ++ai)
#pragma unroll
                for (int m = 0; m < 4; ++m) { bf16_t* rowp = a.O + (size_t)(row0 + ai * HALF + m * 16) * a.ldc + col0;
                    const f32x4 h0 = silu4(acc[ai][0][m][0]) * acc[ai][1][m][0], h1 = silu4(acc[ai][0][m][1]) * acc[ai][1][m][1];
                    *(u32x4*)(rowp) = pack8(h0, h1); }
        } else if constexpr (MODE == EPI_GATEMIX) {
            const int ch0 = u.pn * 128 + wc * 32 + 8 * fq;
            const f32x4 b0a = *(const f32x4*)(a.f0 + ch0), b0b = *(const f32x4*)(a.f0 + ch0 + 4), b1a = *(const f32x4*)(a.f0 + 1024 + ch0), b1b = *(const f32x4*)(a.f0 + 1024 + ch0 + 4);
#pragma unroll
            for (int ai = 0; ai < 2; ++ai)
#pragma unroll
                for (int m = 0; m < 4; ++m) { const size_t off = (size_t)(row0 + ai * HALF + m * 16) * 1024 + ch0;
                    const u32x4 ys = *(const u32x4*)(a.h0 + off), yr = *(const u32x4*)(a.h1 + off);
                    const f32x4 g0a = sigm4(acc[ai][0][m][0] + b0a), g0b = sigm4(acc[ai][0][m][1] + b0b), g1a = sigm4(acc[ai][1][m][0] + b1a), g1b = sigm4(acc[ai][1][m][1] + b1b);
                    const f32x4 oa = g0a * unlo(ys) + g1a * unlo(yr), ob = g0b * unhi(ys) + g1b * unhi(yr);
                    *(u32x4*)(a.O + off) = pack8(oa, ob); }
        } else {
            const int col0 = u.pn * BM + wc * 32 + 8 * fq;
#pragma unroll
            for (int ai = 0; ai < 2; ++ai)
#pragma unroll
                for (int m = 0; m < 4; ++m) {
#pragma unroll
                    for (int bj = 0; bj < 2; ++bj) { const size_t off = (size_t)(row0 + ai * HALF + m * 16) * 1024 + col0 + bj * HALF;
                        const f32x4 ba = *(const f32x4*)(a.f0 + off), bb = *(const f32x4*)(a.f0 + off + 4);
                        *(f32x4*)(a.Of + off) = ba * DN_ALPHA_F + acc[ai][bj][m][0]; *(f32x4*)(a.Of + off + 4) = bb * DN_ALPHA_F + acc[ai][bj][m][1]; } }
        }
    }
};
template <class Epi, class Sched, bool ALIGN_EPI = false, bool SP2 = false>
__device__ __forceinline__ void gemm_phase(PG8_LAS unsigned char* lds, const Gemm g, const Sched& S, const Epi& E) {
    const int tid = threadIdx.x, wid = __builtin_amdgcn_readfirstlane(tid >> 6), lane = tid & 63, wr = wid >> 2, wc = wid & 3, fr = lane & 15, fq = lane >> 4;
    const int K = g.K, nt = K / BK;
    unsigned voffA[2], voffB[2];
#pragma unroll
    for (int i = 0; i < 2; ++i) { int R, C; stage_rc(tid * 16 + i * 8192, R, C); const int Rb = Epi::PERM ? ((R & ~31) + perm32(R & 31)) : R;
        voffA[i] = (unsigned)(R * K + C) * 2u; voffB[i] = (unsigned)(Rb * K + C) * 2u; }
    const size_t kstep = (size_t)(BK * 2);
    const size_t hstep = (size_t)HALF * K * 2;
    const size_t tstep = 2 * hstep;
    const unsigned ldsw = (unsigned)wid * 1024u;
    const int aoff = lds_byte(wr * 64 + fr, fq * 8), boff = lds_byte(wc * 32 + fr, fq * 8);
#define PG8_SA(b, h) (((b) * 2 + (h)) * HTB)
#define PG8_SB(b, h) ((4 + (b) * 2 + (h)) * HTB)
#define PG8_STAGE(bufoff, gbase, voff) do { _Pragma("unroll") for (int _i = 0; _i < 2; ++_i) \
        __builtin_amdgcn_global_load_lds((const unsigned*)((const char*)(gbase) + (voff)[_i]), (PG8_LAS unsigned*)(lds + (bufoff) + ldsw + _i * 8192), 16, 0, 0); } while (0)
#define PG8_LDA(dst, b, h) do { _Pragma("unroll") for (int m = 0; m < 4; ++m) _Pragma("unroll") for (int k = 0; k < 2; ++k) dst[m][k] = *(const PG8_LAS bf16x8*)(lds + PG8_SA(b, h) + aoff + m * 2048 + k * 1024); } while (0)
#define PG8_LDB(dst, b, h) do { _Pragma("unroll") for (int n = 0; n < 2; ++n) _Pragma("unroll") for (int k = 0; k < 2; ++k) dst[n][k] = *(const PG8_LAS bf16x8*)(lds + PG8_SB(b, h) + boff + n * 2048 + k * 1024); } while (0)
#define PG8_MMA(ai, bj, At, Bt) do { __builtin_amdgcn_s_setprio(1); _Pragma("unroll") for (int m = 0; m < 4; ++m) _Pragma("unroll") for (int n = 0; n < 2; ++n) _Pragma("unroll") for (int k = 0; k < 2; ++k) \
        acc[ai][bj][m][n] = __builtin_amdgcn_mfma_f32_16x16x32_bf16(Bt[n][k], At[m][k], acc[ai][bj][m][n], 0, 0, 0); __builtin_amdgcn_s_setprio(0); } while (0)
#define PG8_WAIT_V(n) asm volatile("s_waitcnt vmcnt(" #n ")" ::: "memory")
#define PG8_WAIT_L(n) asm volatile("s_waitcnt lgkmcnt(" #n ")" ::: "memory")
#define PG8_BAR __builtin_amdgcn_s_barrier()
#define PG8_SCHED __builtin_amdgcn_sched_barrier(0)
    Unit cur, nxt; int ui = 0;
    if (!S.next(0, cur)) return;
    f32x4 acc[2][2][4][2];
#pragma unroll
    for (int a = 0; a < 2; ++a)
#pragma unroll
        for (int b = 0; b < 2; ++b)
#pragma unroll
            for (int m = 0; m < 4; ++m)
#pragma unroll
                for (int n = 0; n < 2; ++n) acc[a][b][m][n] = (f32x4){0.f, 0.f, 0.f, 0.f};
    bf16x8 At[4][2], B0[2][2], B1[2][2];
    const char* cA = (const char*)g.A + (size_t)cur.pm * tstep; const char* cB = (const char*)g.Bt + (size_t)cur.pn * tstep;
    S.a_ready(cur);
    if constexpr (SP2) {
        PG8_STAGE(PG8_SB(0, 0), cB, voffB); PG8_STAGE(PG8_SB(0, 1), cB + hstep, voffB); PG8_STAGE(PG8_SA(0, 0), cA, voffA); PG8_STAGE(PG8_SA(0, 1), cA + hstep, voffA);
        if (wr == 1) PG8_BAR;
        PG8_WAIT_V(2); PG8_BAR;
        PG8_STAGE(PG8_SB(1, 0), cB + kstep, voffB); PG8_STAGE(PG8_SA(1, 0), cA + kstep, voffA); PG8_STAGE(PG8_SB(1, 1), cB + hstep + kstep, voffB);
        PG8_WAIT_V(6); PG8_BAR;
    } else {
        PG8_STAGE(PG8_SB(0, 0), cB, voffB); PG8_STAGE(PG8_SA(0, 0), cA, voffA); PG8_STAGE(PG8_SB(0, 1), cB + hstep, voffB); PG8_STAGE(PG8_SA(0, 1), cA + hstep, voffA);
        if (wr == 1) PG8_BAR;
        PG8_WAIT_V(4); PG8_BAR;
        PG8_STAGE(PG8_SB(1, 0), cB + kstep, voffB); PG8_STAGE(PG8_SA(1, 0), cA + kstep, voffA); PG8_STAGE(PG8_SB(1, 1), cB + hstep + kstep, voffB);
        PG8_WAIT_V(6); PG8_BAR;
    }
    for (;;) {
        const bool has_next = S.next(ui + 1, nxt);
        const char* nA = has_next ? (const char*)g.A + (size_t)nxt.pm * tstep : cA; const char* nB = has_next ? (const char*)g.Bt + (size_t)nxt.pn * tstep : cB;
        for (int t = 0; t < nt; t += 2) {
            const bool last = (t == nt - 2);
            const char* a1 = cA + (size_t)(t + 1) * kstep;
            const char* a2 = last ? nA : cA + (size_t)(t + 2) * kstep; const char* b2 = last ? nB : cB + (size_t)(t + 2) * kstep;
            const char* a3 = a2 + kstep; const char* b3 = b2 + kstep;
            if (last && has_next) S.a_ready(nxt);
            if constexpr (SP2) {
            PG8_LDB(B0, 0, 0); PG8_LDB(B1, 0, 1); PG8_SCHED; PG8_LDA(At, 0, 0); PG8_STAGE(PG8_SA(1, 1), a1 + hstep, voffA);
            PG8_WAIT_V(8); PG8_WAIT_L(0); PG8_BAR; PG8_MMA(0, 0, At, B0); PG8_MMA(0, 1, At, B1); PG8_BAR; PG8_SCHED;
            PG8_LDA(At, 0, 1); PG8_STAGE(PG8_SB(0, 0), b2, voffB); PG8_STAGE(PG8_SB(0, 1), b2 + hstep, voffB); PG8_STAGE(PG8_SA(0, 0), a2, voffA);
            PG8_WAIT_V(8); PG8_WAIT_L(0); PG8_BAR; PG8_MMA(1, 0, At, B0); PG8_MMA(1, 1, At, B1); PG8_BAR; PG8_SCHED;
            PG8_LDB(B0, 1, 0); PG8_LDB(B1, 1, 1); PG8_SCHED; PG8_LDA(At, 1, 0); PG8_STAGE(PG8_SA(0, 1), a2 + hstep, voffA);
            PG8_WAIT_V(8); PG8_WAIT_L(0); PG8_BAR; PG8_MMA(0, 0, At, B0); PG8_MMA(0, 1, At, B1); PG8_BAR; PG8_SCHED;
            PG8_LDA(At, 1, 1); PG8_STAGE(PG8_SB(1, 0), b3, voffB); PG8_STAGE(PG8_SB(1, 1), b3 + hstep, voffB); PG8_STAGE(PG8_SA(1, 0), a3, voffA);
            PG8_WAIT_V(8); PG8_WAIT_L(0); PG8_BAR; PG8_MMA(1, 0, At, B0); PG8_MMA(1, 1, At, B1); PG8_BAR; PG8_SCHED;
            } else {
            PG8_LDB(B0, 0, 0); PG8_SCHED; PG8_LDA(At, 0, 0); PG8_STAGE(PG8_SA(1, 1), a1 + hstep, voffA);
            PG8_WAIT_L(8); PG8_BAR; PG8_WAIT_L(0); PG8_MMA(0, 0, At, B0); PG8_BAR; PG8_SCHED;
            PG8_LDB(B1, 0, 1); PG8_STAGE(PG8_SB(0, 0), b2, voffB);
            PG8_BAR; PG8_WAIT_L(0); PG8_MMA(0, 1, At, B1); PG8_BAR;
            PG8_LDA(At, 0, 1); PG8_STAGE(PG8_SA(0, 0), a2, voffA);
            PG8_BAR; PG8_WAIT_L(0); PG8_MMA(1, 0, At, B0); PG8_BAR; PG8_SCHED;
            PG8_STAGE(PG8_SB(0, 1), b2 + hstep, voffB);
            PG8_WAIT_V(6); PG8_BAR; PG8_MMA(1, 1, At, B1); PG8_BAR;
            PG8_LDB(B0, 1, 0); PG8_SCHED; PG8_LDA(At, 1, 0); PG8_STAGE(PG8_SA(0, 1), a2 + hstep, voffA);
            PG8_WAIT_L(8); PG8_BAR; PG8_WAIT_L(0); PG8_MMA(0, 0, At, B0); PG8_BAR; PG8_SCHED;
            PG8_LDB(B1, 1, 1); PG8_STAGE(PG8_SB(1, 0), b3, voffB);
            PG8_BAR; PG8_WAIT_L(0); PG8_MMA(0, 1, At, B1); PG8_BAR;
            PG8_LDA(At, 1, 1); PG8_STAGE(PG8_SA(1, 0), a3, voffA);
            PG8_BAR; PG8_WAIT_L(0); PG8_MMA(1, 0, At, B0); PG8_BAR; PG8_SCHED;
            PG8_STAGE(PG8_SB(1, 1), b3 + hstep, voffB);
            PG8_WAIT_V(6); PG8_BAR; PG8_MMA(1, 1, At, B1); PG8_BAR;
            }
        }
        if constexpr (ALIGN_EPI) { if (wr == 0) PG8_BAR; }
        if constexpr (!Epi::AFTER_DRAIN) { E(acc, cur, wr, wc, fr, fq); S.done(cur); }
        if (!has_next) break;
#pragma unroll
        for (int a = 0; a < 2; ++a)
#pragma unroll
            for (int b = 0; b < 2; ++b)
#pragma unroll
                for (int m = 0; m < 4; ++m)
#pragma unroll
                    for (int n = 0; n < 2; ++n) acc[a][b][m][n] = (f32x4){0.f, 0.f, 0.f, 0.f};
        cur = nxt; cA = nA; cB = nB; ++ui;
        if constexpr (ALIGN_EPI) { if (wr == 1) PG8_BAR; }
    }
    PG8_WAIT_V(0);
    if constexpr (!ALIGN_EPI) { if (wr == 0) PG8_BAR; }
    PG8_BAR;
    if constexpr (Epi::AFTER_DRAIN) { E.fused(acc, cur, wr, wc, fr, fq, lds, wid, lane); S.done(cur); }
#undef PG8_SA
#undef PG8_SB
#undef PG8_STAGE
#undef PG8_LDA
#undef PG8_LDB
#undef PG8_MMA
#undef PG8_WAIT_V
#undef PG8_WAIT_L
#undef PG8_BAR
#undef PG8_SCHED
}
}

namespace cg = cooperative_groups;
#define LAS __attribute__((address_space(3)))
using pg8::bf16_t; using pg8::bf16x8; using pg8::f32x4; using pg8::u32x4;
typedef float f32x16 __attribute__((ext_vector_type(16)));
typedef unsigned u32x2 __attribute__((ext_vector_type(2)));

constexpr int NWAVES = 8;
constexpr int D = 1024, BATCH = 4, SEQ = 8192, TOK = BATCH * SEQ, MEML = 256, INW = 6656, FFH = 2816;
constexpr float LN_EPS = 1e-5f;
constexpr size_t MiB = 1u << 20;
constexpr size_t WS_COS = 1 * MiB, WS_SIN = 3 * MiB, WS_COST = 5 * MiB, WS_SINT = 7 * MiB;
constexpr size_t WS_MEMB = 9 * MiB, WS_MEMK = 11 * MiB, WS_MEMVT = 13 * MiB;
constexpr size_t W_SBQK = 16 * MiB, W_SBV = 18 * MiB, W_RQK = 19 * MiB, W_RV = 21 * MiB, W_RG = 23 * MiB, W_GATE = 25 * MiB, W_SBO = 29 * MiB, W_RETO = 30 * MiB,
                 W_MIXO = 32 * MiB, W_MEMQ = 34 * MiB, W_MEMKV = 36 * MiB, W_MEMO = 40 * MiB, W_FFNI = 42 * MiB, W_FFNO = 53 * MiB;
constexpr size_t WS_XB = 60 * MiB, WS_SBQ = 124 * MiB, WS_SBK = 156 * MiB, WS_SBVT = 188 * MiB, WS_RQ = 220 * MiB, WS_RK = 252 * MiB, WS_RKT = 284 * MiB,
                 WS_RVT = 316 * MiB, WS_RG = 380 * MiB, WS_ST = 444 * MiB, WS_END = 508 * MiB;
constexpr size_t WS_YSB = 220 * MiB, WS_YRET = 284 * MiB, WS_MIXIN = 156 * MiB, WS_QM = 220 * MiB, WS_HID = 284 * MiB;
constexpr int LDS_BYTES = 147456;

__constant__ float INVF[64] = {1.000000000e+00f, 8.659643531e-01f, 7.498942018e-01f, 6.493816376e-01f, 5.623413324e-01f, 4.869675338e-01f, 4.216965139e-01f, 3.651741147e-01f, 3.162277639e-01f, 2.738419771e-01f, 2.371373922e-01f, 2.053525001e-01f, 1.778279394e-01f, 1.539926529e-01f, 1.333521456e-01f, 1.154782027e-01f, 1.000000015e-01f, 8.659642935e-02f, 7.498941571e-02f, 6.493816525e-02f, 5.623412877e-02f, 4.869675264e-02f, 4.216964915e-02f, 3.651741147e-02f, 3.162277862e-02f, 2.738419734e-02f, 2.371373586e-02f, 2.053524926e-02f, 1.778279431e-02f, 1.539926510e-02f, 1.333521493e-02f, 1.154781971e-02f, 9.999999776e-03f, 8.659643121e-03f, 7.498942316e-03f, 6.493816618e-03f, 5.623413250e-03f, 4.869675264e-03f, 4.216964822e-03f, 3.651741426e-03f, 3.162277862e-03f, 2.738419687e-03f, 2.371373819e-03f, 2.053525066e-03f, 1.778279431e-03f, 1.539926627e-03f, 1.333521446e-03f, 1.154781901e-03f, 1.000000047e-03f, 8.659643354e-04f, 7.498941850e-04f, 6.493816618e-04f, 5.623413017e-04f, 4.869675031e-04f, 4.216965463e-04f, 3.651741135e-04f, 3.162277862e-04f, 2.738419571e-04f, 2.371373848e-04f, 2.053525241e-04f, 1.778279402e-04f, 1.539926452e-04f, 1.333521504e-04f, 1.154782076e-04f};

__device__ __forceinline__ f32x16 mfma32(bf16x8 a, bf16x8 b, f32x16 c) { return __builtin_amdgcn_mfma_f32_32x32x16_bf16(a, b, c, 0, 0, 0); }
__device__ __forceinline__ f32x4 mfma16(bf16x8 a, bf16x8 b, f32x4 c) { return __builtin_amdgcn_mfma_f32_16x16x32_bf16(a, b, c, 0, 0, 0); }
__device__ __forceinline__ unsigned pk2(float lo, float hi) { return pg8::cvt_pk_bf16(lo, hi); }
__device__ __forceinline__ float bf_lo(unsigned w) { return __uint_as_float(w << 16); }
__device__ __forceinline__ float bf_hi(unsigned w) { return __uint_as_float(w & 0xffff0000u); }
__device__ __forceinline__ float wave_sum(float v) {
#pragma unroll
    for (int o = 1; o < 64; o <<= 1) v += __shfl_xor(v, o);
    return v;
}

__device__ __forceinline__ int map_row(int mode, int n0) {
    if (mode == 0) return n0;
    if (mode == 1) { const int which = n0 >> 9, hd = n0 & 511, head = hd >> 7, a = (hd >> 6) & 1, i = hd & 63; return which * 512 + (head >> 1) * 256 + a * 128 + (head & 1) * 64 + i; }
    if (mode == 2) { const int br = n0 >> 10, ch = n0 & 1023; return (ch >> 7) * 256 + br * 128 + (ch & 127); }
    const int br = n0 / FFH, hc = n0 % FFH; return (hc >> 7) * 256 + br * 128 + (hc & 127);
}
__device__ __forceinline__ void p0_transpose_item(const float* W, int K, int ldw, int col0, int nblk, bf16_t* WT, int mode, LAS float* scr, int item, int lane) {
    const int kb = item / nblk, nb = item % nblk, k0 = 64 * kb, n0 = 32 * nb;
#pragma unroll 8
    for (int i = 0; i < 32; ++i) { const int kk = 2 * i + (lane >> 5); scr[kk * 33 + (lane & 31)] = W[(size_t)(k0 + kk) * ldw + col0 + n0 + (lane & 31)]; }
    asm volatile("s_waitcnt lgkmcnt(0)" ::: "memory");
    const int c = lane & 7, r0 = map_row(mode, n0);
#pragma unroll
    for (int j = 0; j < 4; ++j) { const int n = (lane >> 3) + 8 * j; const LAS float* s = scr + (8 * c) * 33 + n;
        u32x4 o; o.x = pk2(s[0 * 33], s[1 * 33]); o.y = pk2(s[2 * 33], s[3 * 33]); o.z = pk2(s[4 * 33], s[5 * 33]); o.w = pk2(s[6 * 33], s[7 * 33]);
        *(u32x4*)(WT + (size_t)(r0 + n) * K + k0 + 8 * c) = o; }
    asm volatile("s_waitcnt lgkmcnt(0)" ::: "memory");
}

struct Args { const float* in[18]; float* out; unsigned char* ws; };

__device__ __forceinline__ void p0_prologue(const Args& A, LAS unsigned char* lds, int gw, int NGW, int wave, int lane) {
    LAS float* scr = (LAS float*)(lds + wave * 16384);
    unsigned char* ws = A.ws;
    const float* w_in = A.in[2];
    {
        constexpr int I0 = 16 * 32, I1 = I0 + 16 * 16, I2 = I1 + 16 * 32, I3 = I2 + 16 * 32, I4 = I3 + 16 * 32, I5 = I4 + 16 * 64, I6 = I5 + 8 * 32, I7 = I6 + 16 * 32, I8 = I7 + 16 * 32, I9 = I8 + 16 * 32,
                      I10 = I9 + 16 * 64, I11 = I10 + 16 * 32, I12 = I11 + 16 * 176, I13 = I12 + 44 * 32;
        for (int it0 = gw; it0 < I13; it0 += NGW) {
            const float* W; int K = D, ldw = D, col0 = 0, nblk = 32, mode = 0, it; size_t dst;
            if (it0 < I0) { W = w_in; ldw = INW; dst = W_SBQK; it = it0; }
            else if (it0 < I1) { W = w_in; ldw = INW; col0 = 1024; nblk = 16; dst = W_SBV; it = it0 - I0; }
            else if (it0 < I2) { W = w_in; ldw = INW; col0 = 1536; mode = 1; dst = W_RQK; it = it0 - I1; }
            else if (it0 < I3) { W = w_in; ldw = INW; col0 = 2560; dst = W_RV; it = it0 - I2; }
            else if (it0 < I4) { W = w_in; ldw = INW; col0 = 3584; dst = W_RG; it = it0 - I3; }
            else if (it0 < I5) { W = w_in; ldw = INW; col0 = 4608; nblk = 64; mode = 2; dst = W_GATE; it = it0 - I4; }
            else if (it0 < I6) { W = A.in[4]; K = 512; dst = W_SBO; it = it0 - I5; }
            else if (it0 < I7) { W = A.in[5]; dst = W_RETO; it = it0 - I6; }
            else if (it0 < I8) { W = A.in[6]; dst = W_MIXO; it = it0 - I7; }
            else if (it0 < I9) { W = A.in[9]; dst = W_MEMQ; it = it0 - I8; }
            else if (it0 < I10) { W = A.in[10]; ldw = 2 * D; nblk = 64; dst = W_MEMKV; it = it0 - I9; }
            else if (it0 < I11) { W = A.in[11]; dst = W_MEMO; it = it0 - I10; }
            else if (it0 < I12) { W = A.in[14]; ldw = 2 * FFH; nblk = 176; mode = 3; dst = W_FFNI; it = it0 - I11; }
            else { W = A.in[15]; K = FFH; dst = W_FFNO; it = it0 - I12; }
            p0_transpose_item(W, K, ldw, col0, nblk, (bf16_t*)(ws + dst), mode, scr, it, lane);
        }
    }
    {
        const size_t gt = (size_t)gw * 64 + lane, NT = (size_t)NGW * 64;
        const float* x = A.in[0]; bf16_t* xb = (bf16_t*)(ws + WS_XB);
        for (size_t e = gt; e < (size_t)TOK * D / 8; e += NT) { const f32x4 a = *(const f32x4*)(x + e * 8), b = *(const f32x4*)(x + e * 8 + 4); *(u32x4*)(xb + e * 8) = pg8::pack8(a, b); }
        const float* mem = A.in[1]; bf16_t* mb = (bf16_t*)(ws + WS_MEMB);
        for (size_t e = gt; e < (size_t)BATCH * MEML * D / 8; e += NT) { const f32x4 a = *(const f32x4*)(mem + e * 8), b = *(const f32x4*)(mem + e * 8 + 4); *(u32x4*)(mb + e * 8) = pg8::pack8(a, b); }
        float* ct = (float*)(ws + WS_COS); float* st = (float*)(ws + WS_SIN); float* ctt = (float*)(ws + WS_COST); float* stt = (float*)(ws + WS_SINT);
        for (size_t e = gt; e < (size_t)SEQ * 64; e += NT) { const int pos = (int)(e >> 6), i = (int)(e & 63);
            const float ang = (float)pos * INVF[i]; const double rev = (double)ang * 0.15915494309189535; const float fr = (float)(rev - __builtin_floor(rev));
            const float s = __builtin_amdgcn_sinf(fr), c = __builtin_amdgcn_cosf(fr);
            ct[e] = c; st[e] = s; ctt[(size_t)i * SEQ + pos] = c; stt[(size_t)i * SEQ + pos] = s; }
    }
}

__device__ __forceinline__ void sb_unit(const bf16_t* Q, const bf16_t* K, const bf16_t* VT, bf16_t* O, int b, int h, int qb, int lane) {
    const int q = lane & 31, hi = lane >> 5;
    const size_t rowbase = (size_t)b * SEQ;
    const int q0 = qb * 32, tq = q0 + q;
    const bf16_t* qp = Q + (rowbase + q0 + q) * 512 + h * 64 + 8 * hi;
    bf16x8 qf[4];
#pragma unroll
    for (int ks = 0; ks < 4; ++ks) qf[ks] = *(const bf16x8*)(qp + 16 * ks);
    f32x16 o0 = {}, o1 = {};
    float R = 0.f;
    const int kperm = 16 * ((q >> 2) & 1) + (q & 3) + 4 * (q >> 3);
    const bf16_t* kp = K + (rowbase + kperm) * 512 + h * 64 + 8 * hi;
    const bf16_t* vp = VT + (size_t)(h * 64 + q) * TOK + rowbase + 16 * hi;
    for (int kt = qb; kt >= 0; --kt) {
        const int k0 = kt * 32;
        bf16x8 kf[4];
#pragma unroll
        for (int ks = 0; ks < 4; ++ks) kf[ks] = *(const bf16x8*)(kp + (size_t)k0 * 512 + 16 * ks);
        bf16x8 vf[2][2];
#pragma unroll
        for (int j = 0; j < 2; ++j)
#pragma unroll
            for (int db = 0; db < 2; ++db) vf[j][db] = *(const bf16x8*)(vp + (size_t)(32 * db) * TOK + k0 + 8 * j);
        f32x16 s = {};
#pragma unroll
        for (int ks = 0; ks < 4; ++ks) s = mfma32(kf[ks], qf[ks], s);
        const int key0 = k0 + 16 * hi;
        float lb[16], lr[16]; float tot = 0.f;
#pragma unroll
        for (int r = 0; r < 16; ++r) { const float z = s[r] * 0.125f; const float a = pg8::ex2(-__builtin_fabsf(z) * 1.4426950408889634f);
            const float l = __builtin_amdgcn_logf(1.f + a) * 0.6931471805599453f; const float sp = __builtin_fmaxf(z, 0.f) + l;
            lb[r] = z - sp;
            lr[r] = (key0 + r < tq) ? -sp : 0.f; tot += lr[r]; }
        const float tot_o = __shfl_xor(tot, 32);
        float run = R + (hi == 0 ? tot_o : 0.f);
        float w[16];
#pragma unroll
        for (int r = 15; r >= 0; --r) { w[r] = (key0 + r < tq) ? pg8::fexp(lb[r] + run) : 0.f; run += lr[r]; }
        R += tot + tot_o;
        u32x4 p0, p1;
        p0.x = pk2(w[0], w[1]); p0.y = pk2(w[2], w[3]); p0.z = pk2(w[4], w[5]); p0.w = pk2(w[6], w[7]);
        p1.x = pk2(w[8], w[9]); p1.y = pk2(w[10], w[11]); p1.z = pk2(w[12], w[13]); p1.w = pk2(w[14], w[15]);
        const bf16x8 pf0 = __builtin_bit_cast(bf16x8, p0), pf1 = __builtin_bit_cast(bf16x8, p1);
        o0 = mfma32(vf[0][0], pf0, o0); o1 = mfma32(vf[0][1], pf0, o1);
        o0 = mfma32(vf[1][0], pf1, o0); o1 = mfma32(vf[1][1], pf1, o1);
        if (__all(R < -120.f)) break;
    }
    bf16_t* op = O + (rowbase + q0 + q) * 512 + h * 64 + 4 * hi;
#pragma unroll
    for (int g = 0; g < 4; ++g) {
        u32x2 a; a.x = pk2(o0[4 * g], o0[4 * g + 1]); a.y = pk2(o0[4 * g + 2], o0[4 * g + 3]); *(u32x2*)(op + 8 * g) = a;
        u32x2 c; c.x = pk2(o1[4 * g], o1[4 * g + 1]); c.y = pk2(o1[4 * g + 2], o1[4 * g + 3]); *(u32x2*)(op + 32 + 8 * g) = c;
    }
}

__device__ __forceinline__ float lg2_gamma(int h) { return h == 0 ? -0.04580368961312479f : h == 1 ? -0.02272007650008353f : h == 2 ? -0.011315313227834146f : -0.005646563141142063f; }
__device__ __forceinline__ void ret_kv_unit(const bf16_t* RKT, const bf16_t* RVT, bf16_t* ST, int bh, int n, int dvb, int lane) {
    const int b = bh >> 2, h = bh & 3, c = lane & 31, hi = lane >> 5;
    const size_t tok0 = (size_t)b * SEQ + (size_t)n * 128;
    const float lg = lg2_gamma(h);
    f32x16 acc[4] = {};
    const bf16_t* kp = RKT + (size_t)(h * 128 + c) * TOK + tok0 + 8 * hi;
    const bf16_t* vp = RVT + (size_t)(h * 256 + dvb * 32 + c) * TOK + tok0 + 8 * hi;
#pragma unroll
    for (int ks = 0; ks < 8; ++ks) {
        const u32x4 vr = *(const u32x4*)(vp + 16 * ks);
        const int j0 = 16 * ks + 8 * hi;
        u32x4 vd;
        vd.x = pk2(bf_lo(vr.x) * pg8::ex2(lg * (float)(127 - j0)), bf_hi(vr.x) * pg8::ex2(lg * (float)(126 - j0)));
        vd.y = pk2(bf_lo(vr.y) * pg8::ex2(lg * (float)(125 - j0)), bf_hi(vr.y) * pg8::ex2(lg * (float)(124 - j0)));
        vd.z = pk2(bf_lo(vr.z) * pg8::ex2(lg * (float)(123 - j0)), bf_hi(vr.z) * pg8::ex2(lg * (float)(122 - j0)));
        vd.w = pk2(bf_lo(vr.w) * pg8::ex2(lg * (float)(121 - j0)), bf_hi(vr.w) * pg8::ex2(lg * (float)(120 - j0)));
        const bf16x8 vf = __builtin_bit_cast(bf16x8, vd);
#pragma unroll
        for (int kb = 0; kb < 4; ++kb) { const bf16x8 kf = *(const bf16x8*)(kp + (size_t)(32 * kb) * TOK + 16 * ks); acc[kb] = mfma32(kf, vf, acc[kb]); }
    }
    bf16_t* sp = ST + ((size_t)(bh * 64 + n) * 256 + dvb * 32 + c) * 128 + 4 * hi;
#pragma unroll
    for (int kb = 0; kb < 4; ++kb)
#pragma unroll
        for (int g = 0; g < 4; ++g) { u32x2 a; a.x = pk2(acc[kb][4 * g], acc[kb][4 * g + 1]); a.y = pk2(acc[kb][4 * g + 2], acc[kb][4 * g + 3]); *(u32x2*)(sp + 32 * kb + 8 * g) = a; }
}
__device__ __forceinline__ void ret_scan(bf16_t* ST, size_t gt, size_t NT) {
    for (size_t e = gt; e < (size_t)16 * 8192; e += NT) {
        const int bh = (int)(e >> 13); const size_t off = (e & 8191) * 4;
        const float cd = pg8::ex2(lg2_gamma(bh & 3) * 128.f);
        bf16_t* p = ST + (size_t)bh * 64 * 32768 + off;
        float s0 = 0.f, s1 = 0.f, s2 = 0.f, s3 = 0.f;
#pragma unroll 8
        for (int n = 0; n < 64; ++n) { const u32x2 kv = *(const u32x2*)(p + (size_t)n * 32768);
            u32x2 o; o.x = pk2(s0, s1); o.y = pk2(s2, s3); *(u32x2*)(p + (size_t)n * 32768) = o;
            s0 = s0 * cd + bf_lo(kv.x); s1 = s1 * cd + bf_hi(kv.x); s2 = s2 * cd + bf_lo(kv.y); s3 = s3 * cd + bf_hi(kv.y); }
    }
}
__device__ __forceinline__ void ret_out_unit(const bf16_t* RQ, const bf16_t* RK, const bf16_t* RVT, const bf16_t* ST, bf16_t* RG, int bh, int n, int rb, int lane) {
    const int b = bh >> 2, h = bh & 3, i = lane & 15, g = lane >> 4;
    const size_t tok0 = (size_t)b * SEQ + (size_t)n * 128;
    const int row = 16 * rb + i;
    const float lg = lg2_gamma(h);
    bf16x8 qf[4];
    const bf16_t* qp = RQ + (tok0 + row) * 512 + h * 128 + 8 * g;
#pragma unroll
    for (int ks = 0; ks < 4; ++ks) qf[ks] = *(const bf16x8*)(qp + 32 * ks);
    f32x4 acc[16];
    const bf16_t* sp = ST + ((size_t)(bh * 64 + n) * 256 + i) * 128 + 8 * g;
#pragma unroll
    for (int db = 0; db < 16; ++db) { f32x4 a = {0.f, 0.f, 0.f, 0.f};
#pragma unroll
        for (int ks = 0; ks < 4; ++ks) { const bf16x8 sf = *(const bf16x8*)(sp + (size_t)(16 * db) * 128 + 32 * ks); a = mfma16(sf, qf[ks], a); }
        acc[db] = a; }
    const float qd = pg8::ex2(lg * (float)(row + 1));
#pragma unroll
    for (int db = 0; db < 16; ++db) acc[db] = acc[db] * qd;
    const bf16_t* kp = RK + (tok0 + 8 * (i >> 2) + (i & 3)) * 512 + h * 128 + 8 * g;
    const bf16_t* vp = RVT + (size_t)(h * 256 + i) * TOK + tok0 + 8 * g;
    const int ns = (rb >> 1) + 1;
    for (int s = 0; s < ns; ++s) {
        f32x4 c0 = {0.f, 0.f, 0.f, 0.f}, c1 = {0.f, 0.f, 0.f, 0.f};
#pragma unroll
        for (int ks = 0; ks < 4; ++ks) { const bf16x8 k0 = *(const bf16x8*)(kp + (size_t)(32 * s) * 512 + 32 * ks), k1 = *(const bf16x8*)(kp + (size_t)(32 * s + 4) * 512 + 32 * ks);
            c0 = mfma16(k0, qf[ks], c0); c1 = mfma16(k1, qf[ks], c1); }
        const int j0 = 32 * s + 8 * g;
        float p[8];
#pragma unroll
        for (int e = 0; e < 4; ++e) { const int ja = j0 + e, jb = j0 + 4 + e;
            p[e] = (ja <= row) ? c0[e] * pg8::ex2(lg * (float)(row - ja)) : 0.f; p[4 + e] = (jb <= row) ? c1[e] * pg8::ex2(lg * (float)(row - jb)) : 0.f; }
        u32x4 pw; pw.x = pk2(p[0], p[1]); pw.y = pk2(p[2], p[3]); pw.z = pk2(p[4], p[5]); pw.w = pk2(p[6], p[7]);
        const bf16x8 pf = __builtin_bit_cast(bf16x8, pw);
#pragma unroll
        for (int db = 0; db < 16; ++db) { const bf16x8 vf = *(const bf16x8*)(vp + (size_t)(16 * db) * TOK + 32 * s); acc[db] = mfma16(vf, pf, acc[db]); }
    }
    float sum = 0.f;
#pragma unroll
    for (int db = 0; db < 16; ++db) sum += (acc[db][0] + acc[db][1]) + (acc[db][2] + acc[db][3]);
    sum += __shfl_xor(sum, 16); sum += __shfl_xor(sum, 32);
    const float mean = sum * (1.f / 256.f); float sq = 0.f;
#pragma unroll
    for (int db = 0; db < 16; ++db) { const f32x4 d = acc[db] - mean; sq += (d[0] * d[0] + d[1] * d[1]) + (d[2] * d[2] + d[3] * d[3]); }
    sq += __shfl_xor(sq, 16); sq += __shfl_xor(sq, 32);
    const float rstd = 1.f / __builtin_sqrtf(sq * (1.f / 256.f) + LN_EPS);
    bf16_t* gp = RG + (tok0 + row) * 1024 + h * 256 + 4 * g;
#pragma unroll
    for (int db = 0; db < 16; ++db) { const u32x2 gv = *(const u32x2*)(gp + 16 * db); const f32x4 d = (acc[db] - mean) * rstd;
        u32x2 o; o.x = pk2(d[0] * bf_lo(gv.x), d[1] * bf_hi(gv.x)); o.y = pk2(d[2] * bf_lo(gv.y), d[3] * bf_hi(gv.y)); *(u32x2*)(gp + 16 * db) = o; }
}

__device__ __forceinline__ void xattn_unit(bf16_t* QM, const bf16_t* MK, const bf16_t* MVT, int b, int mh, int rblk, int lane) {
    const int i = lane & 15, g = lane >> 4;
    const size_t row = (size_t)b * SEQ + (size_t)rblk * 16 + i;
    bf16_t* qp = QM + row * 1024 + mh * 256 + 8 * g;
    bf16x8 qf[8];
#pragma unroll
    for (int ks = 0; ks < 8; ++ks) qf[ks] = *(const bf16x8*)(qp + 32 * ks);
    f32x4 c[16];
    const bf16_t* kp = MK + ((size_t)b * MEML + 8 * (i >> 2) + (i & 3)) * 1024 + mh * 256 + 8 * g;
#pragma unroll
    for (int mb = 0; mb < 16; ++mb) { f32x4 a = {0.f, 0.f, 0.f, 0.f};
#pragma unroll
        for (int ks = 0; ks < 8; ++ks) { const bf16x8 kf = *(const bf16x8*)(kp + (size_t)(32 * (mb >> 1) + 4 * (mb & 1)) * 1024 + 32 * ks); a = mfma16(kf, qf[ks], a); }
        c[mb] = a; }
    float mx = -3.0e38f;
#pragma unroll
    for (int mb = 0; mb < 16; ++mb) mx = __builtin_fmaxf(mx, __builtin_fmaxf(__builtin_fmaxf(c[mb][0], c[mb][1]), __builtin_fmaxf(c[mb][2], c[mb][3])));
    mx = __builtin_fmaxf(mx, __shfl_xor(mx, 16)); mx = __builtin_fmaxf(mx, __shfl_xor(mx, 32));
    const float sc = 0.0625f * 1.4426950408889634f; float sum = 0.f;
#pragma unroll
    for (int mb = 0; mb < 16; ++mb)
#pragma unroll
        for (int e = 0; e < 4; ++e) { const float p = pg8::ex2((c[mb][e] - mx) * sc); c[mb][e] = p; sum += p; }
    sum += __shfl_xor(sum, 16); sum += __shfl_xor(sum, 32);
    const float rs = 1.f / sum;
    bf16x8 pf[8];
#pragma unroll
    for (int s = 0; s < 8; ++s) { u32x4 w; w.x = pk2(c[2 * s][0], c[2 * s][1]); w.y = pk2(c[2 * s][2], c[2 * s][3]); w.z = pk2(c[2 * s + 1][0], c[2 * s + 1][1]); w.w = pk2(c[2 * s + 1][2], c[2 * s + 1][3]); pf[s] = __builtin_bit_cast(bf16x8, w); }
    const bf16_t* vp = MVT + (size_t)(mh * 256 + i) * 1024 + b * MEML + 8 * g;
    bf16_t* op = QM + row * 1024 + mh * 256 + 4 * g;
#pragma unroll
    for (int db = 0; db < 16; ++db) { f32x4 o = {0.f, 0.f, 0.f, 0.f};
#pragma unroll
        for (int s = 0; s < 8; ++s) { const bf16x8 vf = *(const bf16x8*)(vp + (size_t)(16 * db) * 1024 + 32 * s); o = mfma16(vf, pf[s], o); }
        o = o * rs; u32x2 w; w.x = pk2(o[0], o[1]); w.y = pk2(o[2], o[3]); *(u32x2*)(op + 16 * db) = w; }
}

__device__ __forceinline__ void ln_pass(float* io, const float* gam, const float* bet, bf16_t* ob, int gw, int NGW, int lane) {
    f32x4 gv[4], bv[4];
#pragma unroll
    for (int j = 0; j < 4; ++j) { gv[j] = *(const f32x4*)(gam + 4 * lane + 256 * j); bv[j] = *(const f32x4*)(bet + 4 * lane + 256 * j); }
    for (int m = gw; m < TOK; m += NGW) {
        float* xr = io + (size_t)m * D + 4 * lane;
        f32x4 v[4]; float s = 0.f;
#pragma unroll
        for (int j = 0; j < 4; ++j) { v[j] = *(const f32x4*)(xr + 256 * j); s += (v[j][0] + v[j][1]) + (v[j][2] + v[j][3]); }
        const float mean = wave_sum(s) * (1.f / D); float s2 = 0.f;
#pragma unroll
        for (int j = 0; j < 4; ++j) { v[j] = v[j] - mean; s2 += (v[j][0] * v[j][0] + v[j][1] * v[j][1]) + (v[j][2] * v[j][2] + v[j][3] * v[j][3]); }
        const float rstd = 1.f / __builtin_sqrtf(wave_sum(s2) * (1.f / D) + LN_EPS);
#pragma unroll
        for (int j = 0; j < 4; ++j) { const f32x4 y = v[j] * rstd * gv[j] + bv[j]; *(f32x4*)(xr + 256 * j) = y;
            if (ob) { u32x2 w; w.x = pk2(y[0], y[1]); w.y = pk2(y[2], y[3]); *(u32x2*)(ob + (size_t)m * D + 4 * lane + 256 * j) = w; } }
    }
}

template <int MODE> __device__ __forceinline__ void run_gemm(LAS unsigned char* lds, const bf16_t* A, const bf16_t* Bt, int M, int N, int K, const pg8::EpiArgs& ea) {
    pg8::Gemm g{A, Bt, M, N, K}; pg8::StaticOrder S; S.init(M, N, (int)gridDim.x, (int)blockIdx.x);
    pg8::Epi<MODE> E{ea};
    pg8::gemm_phase<pg8::Epi<MODE>, pg8::StaticOrder, true, true>(lds, g, S, E);
}

__global__ void __launch_bounds__(NWAVES * 64, 2) mega_fwd(Args args) {
    extern __shared__ __attribute__((aligned(16))) unsigned char lds_raw[];
    LAS unsigned char* lds = (LAS unsigned char*)lds_raw;
    cg::grid_group grid = cg::this_grid();
    const int tid = threadIdx.x, lane = tid & 63, wave = __builtin_amdgcn_readfirstlane(tid >> 6);
    const int G = gridDim.x, gw = blockIdx.x * NWAVES + wave, NGW = G * NWAVES;
    unsigned char* ws = args.ws;
#define WSB(off) ((bf16_t*)(ws + (off)))
    bf16_t* XB = WSB(WS_XB);
    const float* cosT = (const float*)(ws + WS_COS); const float* sinT = (const float*)(ws + WS_SIN);
    const float* cosTT = (const float*)(ws + WS_COST); const float* sinTT = (const float*)(ws + WS_SINT);

    p0_prologue(args, lds, gw, NGW, wave, lane);
    grid.sync();

    {
        pg8::EpiArgs e{};
        e = pg8::EpiArgs{}; e.O = WSB(WS_SBQ); e.O2 = WSB(WS_SBK); e.ldc = 512; e.split_pn = 2; e.scale0 = 1.f; e.scale1 = 1.f;
        run_gemm<pg8::EPI_PLAIN>(lds, XB, WSB(W_SBQK), TOK, 1024, D, e);
        e = pg8::EpiArgs{}; e.O = WSB(WS_SBVT); e.ldc = TOK; e.scale0 = 1.f;
        run_gemm<pg8::EPI_PLAIN>(lds, WSB(W_SBV), XB, 512, TOK, D, e);
        e = pg8::EpiArgs{}; e.O = WSB(WS_RQ); e.O2 = WSB(WS_RK); e.ldc = 512; e.scale0 = 0.08838834764831845f; e.scale1 = 1.f; e.f0 = cosT; e.f1 = sinT;
        run_gemm<pg8::EPI_ROT>(lds, XB, WSB(W_RQK), TOK, 1024, D, e);
        e = pg8::EpiArgs{}; e.O = WSB(WS_RKT); e.ldc = TOK; e.f0 = cosTT; e.f1 = sinTT;
        run_gemm<pg8::EPI_ROTT>(lds, WSB(W_RQK) + (size_t)512 * D, XB, 512, TOK, D, e);
        e = pg8::EpiArgs{}; e.O = WSB(WS_RVT); e.ldc = TOK; e.scale0 = 1.f;
        run_gemm<pg8::EPI_PLAIN>(lds, WSB(W_RV), XB, 1024, TOK, D, e);
        e = pg8::EpiArgs{}; e.O = WSB(WS_RG); e.ldc = 1024;
        run_gemm<pg8::EPI_SILU>(lds, XB, WSB(W_RG), TOK, 1024, D, e);
        e = pg8::EpiArgs{}; e.O = WSB(WS_MEMK); e.ldc = 1024; e.scale0 = 1.f;
        run_gemm<pg8::EPI_PLAIN>(lds, WSB(WS_MEMB), WSB(W_MEMKV), BATCH * MEML, 1024, D, e);
        e = pg8::EpiArgs{}; e.O = WSB(WS_MEMVT); e.ldc = BATCH * MEML; e.scale0 = 1.f;
        run_gemm<pg8::EPI_PLAIN>(lds, WSB(W_MEMKV) + (size_t)1024 * D, WSB(WS_MEMB), 1024, BATCH * MEML, D, e);
    }
    grid.sync();

    for (int u = gw; u < 16 * 64 * 8; u += NGW) ret_kv_unit(WSB(WS_RKT), WSB(WS_RVT), WSB(WS_ST), u >> 9, (u >> 3) & 63, u & 7, lane);
    for (int u = gw; u < BATCH * 8 * 256; u += NGW) sb_unit(WSB(WS_SBQ), WSB(WS_SBK), WSB(WS_SBVT), WSB(WS_SBQ), u >> 11, (u >> 8) & 7, u & 255, lane);
    grid.sync();
    ret_scan(WSB(WS_ST), (size_t)gw * 64 + lane, (size_t)NGW * 64);
    grid.sync();
    for (int u = gw; u < 16 * 64 * 8; u += NGW) ret_out_unit(WSB(WS_RQ), WSB(WS_RK), WSB(WS_RVT), WSB(WS_ST), WSB(WS_RG), u >> 9, (u >> 3) & 63, u & 7, lane);
    grid.sync();
    {
        pg8::EpiArgs e{}; e.O = WSB(WS_YSB); e.ldc = 1024; e.scale0 = 1.f;
        run_gemm<pg8::EPI_PLAIN>(lds, WSB(WS_SBQ), WSB(W_SBO), TOK, 1024, 512, e);
        e = pg8::EpiArgs{}; e.O = WSB(WS_YRET); e.ldc = 1024; e.scale0 = 1.f;
        run_gemm<pg8::EPI_PLAIN>(lds, WSB(WS_RG), WSB(W_RETO), TOK, 1024, D, e);
    }
    grid.sync();
    {
        pg8::EpiArgs e{}; e.O = WSB(WS_MIXIN); e.ldc = 1024; e.f0 = args.in[3]; e.h0 = WSB(WS_YSB); e.h1 = WSB(WS_YRET);
        run_gemm<pg8::EPI_GATEMIX>(lds, XB, WSB(W_GATE), TOK, 2048, D, e);
    }
    grid.sync();
    {
        pg8::EpiArgs e{}; e.f0 = args.in[0]; e.Of = args.out;
        run_gemm<pg8::EPI_RES>(lds, WSB(WS_MIXIN), WSB(W_MIXO), TOK, 1024, D, e);
    }
    grid.sync();
    ln_pass(args.out, args.in[7], args.in[8], XB, gw, NGW, lane);
    grid.sync();
    {
        pg8::EpiArgs e{}; e.O = WSB(WS_QM); e.ldc = 1024; e.scale0 = 1.f;
        run_gemm<pg8::EPI_PLAIN>(lds, XB, WSB(W_MEMQ), TOK, 1024, D, e);
    }
    grid.sync();
    for (int u = gw; u < BATCH * 4 * (SEQ / 16); u += NGW) xattn_unit(WSB(WS_QM), WSB(WS_MEMK), WSB(WS_MEMVT), u >> 11, (u >> 9) & 3, u & 511, lane);
    grid.sync();
    {
        pg8::EpiArgs e{}; e.f0 = args.out; e.Of = args.out;
        run_gemm<pg8::EPI_RES>(lds, WSB(WS_QM), WSB(W_MEMO), TOK, 1024, D, e);
    }
    grid.sync();
    ln_pass(args.out, args.in[12], args.in[13], XB, gw, NGW, lane);
    grid.sync();
    {
        pg8::EpiArgs e{}; e.O = WSB(WS_HID); e.ldc = FFH;
        run_gemm<pg8::EPI_SWIGLU>(lds, XB, WSB(W_FFNI), TOK, 2 * FFH, D, e);
    }
    grid.sync();
    {
        pg8::EpiArgs e{}; e.f0 = args.out; e.Of = args.out;
        run_gemm<pg8::EPI_RES>(lds, WSB(WS_HID), WSB(W_FFNO), TOK, 1024, FFH, e);
    }
    grid.sync();
    ln_pass(args.out, args.in[16], args.in[17], nullptr, gw, NGW, lane);
#undef WSB
}

extern "C" void kernel_launch(void* const* d_in, const int* in_sizes, int n_in, void* d_out, int out_size, void* d_ws, size_t ws_size, hipStream_t stream) {
    static int grid = 0;
    if (grid == 0) {
        if (n_in != 18 || out_size != TOK * D || ws_size < WS_END) { fprintf(stderr, "kernel_launch: unexpected problem shape (n_in %d out %d ws %zu)\n", n_in, out_size, ws_size); grid = -1; return; }
        int dev = 0, cus = 0, per_cu = 0;
        hipGetDevice(&dev); hipDeviceGetAttribute(&cus, hipDeviceAttributeMultiprocessorCount, dev);
        hipFuncSetAttribute((const void*)mega_fwd, hipFuncAttributeMaxDynamicSharedMemorySize, LDS_BYTES);
        hipOccupancyMaxActiveBlocksPerMultiprocessor(&per_cu, (const void*)mega_fwd, NWAVES * 64, LDS_BYTES);
        if (per_cu < 1) { fprintf(stderr, "kernel_launch: occupancy query says %d blocks per CU\n", per_cu); per_cu = 1; }
        grid = cus;
        (void)hipGetLastError();
    }
    if (grid < 0) return;
    Args a{};
    for (int i = 0; i < 18; ++i) a.in[i] = (const float*)d_in[i];
    a.out = (float*)d_out; a.ws = (unsigned char*)d_ws;
    void* kargs[] = {&a};
    hipError_t e = hipLaunchCooperativeKernel((const void*)mega_fwd, dim3(grid), dim3(NWAVES * 64), kargs, LDS_BYTES, stream);
    if (e != hipSuccess) fprintf(stderr, "cooperative launch failed: %s (grid %d)\n", hipGetErrorString(e), grid);
}
```

```cpp
#include <hip/hip_cooperative_groups.h>
#include <hip/hip_runtime.h>
#include <cstdio>
#include <cstdint>
namespace pg8 {
#define PG8_LAS __attribute__((address_space(3)))
typedef unsigned short bf16_t;
typedef short bf16x8 __attribute__((ext_vector_type(8)));
typedef float f32x4 __attribute__((ext_vector_type(4)));
typedef unsigned u32x4 __attribute__((ext_vector_type(4)));
constexpr int BM = 256, BK = 64, HALF = 128, HTB = HALF * BK * 2  , STAGE_BYTES = 8 * HTB, NXCD = 8, WGM = 8;

__host__ __device__ __forceinline__ int lds_byte(int r, int c) { const int st = (r >> 4) * 2 + (c >> 5), rr = r & 15, cc = c & 31, ob = rr * 64 + cc * 2; return st * 1024 + (ob ^ (((ob >> 9) & 1) << 5)); }
__host__ __device__ __forceinline__ void stage_rc(int b, int& R, int& C) { const int st = b / 1024, sb = b % 1024, swz = sb ^ (((sb >> 9) & 1) << 5); R = (st >> 1) * 16 + swz / 64; C = (st & 1) * 32 + (swz % 64) / 2; }
__host__ __device__ __forceinline__ int perm32(int rho) { const int n = rho >> 4, i = rho & 15; return 8 * (i >> 2) + 4 * n + (i & 3); }

struct Unit { int pm, pn; };
struct Gemm { const bf16_t* A; const bf16_t* Bt; int M, N, K; };

struct StaticOrder {
    int nM, nN, nwg, G, c;
    __host__ __device__ void init(int M, int N, int G_, int c_) { nM = M / BM; nN = N / BM; nwg = nM * nN; G = G_; c = c_; }
    __host__ __device__ bool next(int i, Unit& u) const {
        const long L = (long)i * G + c; if (L >= nwg) return false;
        int wgid = (int)L; { const int q = nwg / NXCD, r = nwg % NXCD, xcd = wgid % NXCD, off = wgid / NXCD; wgid = (xcd < r ? xcd * (q + 1) : r * (q + 1) + (xcd - r) * q) + off; }
        const int nig = WGM * nN, gid = wgid / nig, fm = gid * WGM, gsz = (nM - fm) < WGM ? (nM - fm) : WGM;
        u.pm = fm + ((wgid % nig) % gsz); u.pn = (wgid % nig) / gsz; return true;
    }
    __device__ __forceinline__ void a_ready(const Unit&) const {}
    __device__ __forceinline__ void done(const Unit&) const {}
};

__device__ __forceinline__ unsigned cvt_pk_bf16(float lo, float hi) { unsigned r; asm volatile("v_cvt_pk_bf16_f32 %0, %1, %2" : "=v"(r) : "v"(lo), "v"(hi)); return r; }
typedef float f32x2 __attribute__((ext_vector_type(2)));
__device__ __forceinline__ float ex2(float x) { return __builtin_amdgcn_exp2f(x); }
__device__ __forceinline__ float fexp(float x) { return __builtin_amdgcn_exp2f(x * 1.4426950408889634f); }
__device__ __forceinline__ float sigm(float x) { return __builtin_amdgcn_rcpf(1.f + fexp(-x)); }
__device__ __forceinline__ float silu1(float x) { return x * sigm(x); }
__device__ __forceinline__ f32x4 silu4(f32x4 v) { return (f32x4){silu1(v[0]), silu1(v[1]), silu1(v[2]), silu1(v[3])}; }
__device__ __forceinline__ f32x4 sigm4(f32x4 v) { return (f32x4){sigm(v[0]), sigm(v[1]), sigm(v[2]), sigm(v[3])}; }
__device__ __forceinline__ u32x4 pack8(f32x4 a, f32x4 b) { u32x4 w; w.x = cvt_pk_bf16(a[0], a[1]); w.y = cvt_pk_bf16(a[2], a[3]); w.z = cvt_pk_bf16(b[0], b[1]); w.w = cvt_pk_bf16(b[2], b[3]); return w; }
__device__ __forceinline__ f32x4 unlo(u32x4 w) { return (f32x4){__uint_as_float(w.x << 16), __uint_as_float(w.x & 0xffff0000u), __uint_as_float(w.y << 16), __uint_as_float(w.y & 0xffff0000u)}; }
__device__ __forceinline__ f32x4 unhi(u32x4 w) { return (f32x4){__uint_as_float(w.z << 16), __uint_as_float(w.z & 0xffff0000u), __uint_as_float(w.w << 16), __uint_as_float(w.w & 0xffff0000u)}; }

typedef unsigned u32x2v __attribute__((ext_vector_type(2)));
enum { EPI_PLAIN = 0, EPI_ROT = 1, EPI_ROTT = 2, EPI_SILU = 3, EPI_SWIGLU = 4, EPI_GATEMIX = 5, EPI_RES = 6 };
struct EpiArgs {
    bf16_t* O; bf16_t* O2; int ldc; int split_pn; float scale0, scale1;
    const float* f0; const float* f1;
    const bf16_t* h0; const bf16_t* h1;
    float* Of;
};
constexpr int TOKS = 32768, SEQL = 8192;
constexpr float DN_ALPHA_F = 1.189207115002721f;

template <int MODE> struct Epi {
    static constexpr bool PERM = true, AFTER_DRAIN = false;
    EpiArgs a;
    __device__ __forceinline__ void operator()(const f32x4 (&acc)[2][2][4][2], const Unit& u, int wr, int wc, int fr, int fq) const {
        const int row0 = u.pm * BM + wr * 64 + fr;
        if constexpr (MODE == EPI_PLAIN || MODE == EPI_SILU) {
            int pn = u.pn; bf16_t* base = a.O; float sc = a.scale0;
            if (a.split_pn > 0 && pn >= a.split_pn) { pn -= a.split_pn; base = a.O2; sc = a.scale1; }
            const int col0 = pn * BM + wc * 32 + 8 * fq;
#pragma unroll
            for (int ai = 0; ai < 2; ++ai)
#pragma unroll
                for (int m = 0; m < 4; ++m) { bf16_t* rowp = base + (size_t)(row0 + ai * HALF + m * 16) * a.ldc + col0;
#pragma unroll
                    for (int bj = 0; bj < 2; ++bj) { f32x4 v0 = acc[ai][bj][m][0], v1 = acc[ai][bj][m][1];
                        if constexpr (MODE == EPI_SILU) { v0 = silu4(v0); v1 = silu4(v1); } else { v0 = v0 * sc; v1 = v1 * sc; }
                        *(u32x4*)(rowp + bj * HALF) = pack8(v0, v1); } }
        } else if constexpr (MODE == EPI_ROT) {
            int pn = u.pn; bf16_t* base = a.O; float sc = a.scale0;
            if (pn >= 2) { pn -= 2; base = a.O2; sc = a.scale1; }
            const int head = 2 * pn + (wc >> 1), i0 = 32 * (wc & 1) + 8 * fq, ocol = head * 128 + i0;
#pragma unroll
            for (int ai = 0; ai < 2; ++ai)
#pragma unroll
                for (int m = 0; m < 4; ++m) { const int row = row0 + ai * HALF + m * 16, pos = row & (SEQL - 1);
                    const f32x4 c0 = *(const f32x4*)(a.f0 + pos * 64 + i0), c1 = *(const f32x4*)(a.f0 + pos * 64 + i0 + 4);
                    const f32x4 s0 = *(const f32x4*)(a.f1 + pos * 64 + i0), s1 = *(const f32x4*)(a.f1 + pos * 64 + i0 + 4);
                    const f32x4 x1a = acc[ai][0][m][0], x1b = acc[ai][0][m][1], x2a = acc[ai][1][m][0], x2b = acc[ai][1][m][1];
                    const f32x4 o1a = (x1a * c0 - x2a * s0) * sc, o1b = (x1b * c1 - x2b * s1) * sc, o2a = (x1a * s0 + x2a * c0) * sc, o2b = (x1b * s1 + x2b * c1) * sc;
                    bf16_t* rowp = base + (size_t)row * 512 + ocol;
                    *(u32x4*)(rowp) = pack8(o1a, o1b); *(u32x4*)(rowp + 64) = pack8(o2a, o2b); }
        } else if constexpr (MODE == EPI_ROTT) {
            const unsigned tokb = (unsigned)(u.pn * BM + wc * 32 + 8 * fq);
            const unsigned tb = (unsigned)fr * SEQL + (tokb & (SEQL - 1));
            const unsigned ob = (unsigned)((2 * u.pm + wr) * 128 + fr) * (unsigned)a.ldc + tokb;
#pragma unroll
            for (int m = 0; m < 4; ++m)
#pragma unroll
                for (int bj = 0; bj < 2; ++bj)
#pragma unroll
                    for (int n = 0; n < 2; ++n) { const unsigned to = tb + (unsigned)(m * 16 * SEQL + bj * HALF + n * 4);
                        const f32x4 c0 = *(const f32x4*)(a.f0 + to), s0 = *(const f32x4*)(a.f1 + to);
                        const f32x4 x1 = acc[0][bj][m][n], x2 = acc[1][bj][m][n];
                        const f32x4 o1 = x1 * c0 - x2 * s0, o2 = x1 * s0 + x2 * c0;
                        const unsigned oo = ob + (unsigned)(m * 16) * (unsigned)a.ldc + (unsigned)(bj * HALF + n * 4);
                        u32x2v w1, w2; w1.x = cvt_pk_bf16(o1[0], o1[1]); w1.y = cvt_pk_bf16(o1[2], o1[3]); w2.x = cvt_pk_bf16(o2[0], o2[1]); w2.y = cvt_pk_bf16(o2[2], o2[3]);
                        *(u32x2v*)(a.O + oo) = w1; *(u32x2v*)(a.O + oo + 64u * (unsigned)a.ldc) = w2; }
        } else if constexpr (MODE == EPI_SWIGLU) {
            const int col0 = u.pn * 128 + wc * 32 + 8 * fq;
#pragma unroll
            for (int ai = 0; ai < 2; ++ai)
#pragma unroll
                for (int m = 0; m < 4; ++m) { bf16_t* rowp = a.O + (size_t)(row0 + ai * HALF + m * 16) * a.ldc + col0;
                    const f32x4 h0 = silu4(acc[ai][0][m][0]) * acc[ai][1][m][0], h1 = silu4(acc[ai][0][m][1]) * acc[ai][1][m][1];
                    *(u32x4*)(rowp) = pack8(h0, h1); }
        } else if constexpr (MODE == EPI_GATEMIX) {
            const int ch0 = u.pn * 128 + wc * 32 + 8 * fq;
            const f32x4 b0a = *(const f32x4*)(a.f0 + ch0), b0b = *(const f32x4*)(a.f0 + ch0 + 4), b1a = *(const f32x4*)(a.f0 + 1024 + ch0), b1b = *(const f32x4*)(a.f0 + 1024 + ch0 + 4);
#pragma unroll
            for (int ai = 0; ai < 2; ++ai)
#pragma unroll
                for (int m = 0; m < 4; ++m) { const size_t off = (size_t)(row0 + ai * HALF + m * 16) * 1024 + ch0;
                    const u32x4 ys = *(const u32x4*)(a.h0 + off), yr = *(const u32x4*)(a.h1 + off);
                    const f32x4 g0a = sigm4(acc[ai][0][m][0] + b0a), g0b = sigm4(acc[ai][0][m][1] + b0b), g1a = sigm4(acc[ai][1][m][0] + b1a), g1b = sigm4(acc[ai][1][m][1] + b1b);
                    const f32x4 oa = g0a * unlo(ys) + g1a * unlo(yr), ob = g0b * unhi(ys) + g1b * unhi(yr);
                    *(u32x4*)(a.O + off) = pack8(oa, ob); }
        } else {
            const int col0 = u.pn * BM + wc * 32 + 8 * fq;
#pragma unroll
            for (int ai = 0; ai < 2; ++ai)
#pragma unroll
                for (int m = 0; m < 4; ++m) {
#pragma unroll
                    for (int bj = 0; bj < 2; ++bj) { const size_t off = (size_t)(row0 + ai * HALF + m * 16) * 1024 + col0 + bj * HALF;
                        const f32x4 ba = *(const f32x4*)(a.f0 + off), bb = *(const f32x4*)(a.f0 + off + 4);
                        *(f32x4*)(a.Of + off) = ba * DN_ALPHA_F + acc[ai][bj][m][0]; *(f32x4*)(a.Of + off + 4) = bb * DN_ALPHA_F + acc[ai][bj][m][1]; } }
        }
    }
};
template <class Epi, class Sched, bool ALIGN_EPI = false, bool SP2 = false>
__device__ __forceinline__ void gemm_phase(PG8_LAS unsigned char* lds, const Gemm g, const Sched& S, const Epi& E) {
    int tid_ = threadIdx.x; asm volatile("" : "+v"(tid_));
    const int tid = tid_, wid = __builtin_amdgcn_readfirstlane(tid >> 6), lane = tid & 63, wr = wid >> 2, wc = wid & 3, fr = lane & 15, fq = lane >> 4;
    const int K = g.K, nt = K / BK;
    unsigned voffA[2], voffB[2];
#pragma unroll
    for (int i = 0; i < 2; ++i) { int R, C; stage_rc(tid * 16 + i * 8192, R, C); const int Rb = Epi::PERM ? ((R & ~31) + perm32(R & 31)) : R;
        voffA[i] = (unsigned)(R * K + C) * 2u; voffB[i] = (unsigned)(Rb * K + C) * 2u; }
    const size_t kstep = (size_t)(BK * 2);
    const size_t hstep = (size_t)HALF * K * 2;
    const size_t tstep = 2 * hstep;
    const unsigned ldsw = (unsigned)wid * 1024u;
    const int aoff = lds_byte(wr * 64 + fr, fq * 8), boff = lds_byte(wc * 32 + fr, fq * 8);
#define PG8_SA(b, h) (((b) * 2 + (h)) * HTB)
#define PG8_SB(b, h) ((4 + (b) * 2 + (h)) * HTB)
#define PG8_STAGE(bufoff, gbase, voff) do { _Pragma("unroll") for (int _i = 0; _i < 2; ++_i) \
        __builtin_amdgcn_global_load_lds((const unsigned*)((const char*)(gbase) + (voff)[_i]), (PG8_LAS unsigned*)(lds + (bufoff) + ldsw + _i * 8192), 16, 0, 0); } while (0)
#define PG8_LDA(dst, b, h) do { _Pragma("unroll") for (int m = 0; m < 4; ++m) _Pragma("unroll") for (int k = 0; k < 2; ++k) dst[m][k] = *(const PG8_LAS bf16x8*)(lds + PG8_SA(b, h) + aoff + m * 2048 + k * 1024); } while (0)
#define PG8_LDB(dst, b, h) do { _Pragma("unroll") for (int n = 0; n < 2; ++n) _Pragma("unroll") for (int k = 0; k < 2; ++k) dst[n][k] = *(const PG8_LAS bf16x8*)(lds + PG8_SB(b, h) + boff + n * 2048 + k * 1024); } while (0)
#define PG8_MMA(ai, bj, At, Bt) do { __builtin_amdgcn_s_setprio(1); _Pragma("unroll") for (int m = 0; m < 4; ++m) _Pragma("unroll") for (int n = 0; n < 2; ++n) _Pragma("unroll") for (int k = 0; k < 2; ++k) \
        acc[ai][bj][m][n] = __builtin_amdgcn_mfma_f32_16x16x32_bf16(Bt[n][k], At[m][k], acc[ai][bj][m][n], 0, 0, 0); __builtin_amdgcn_s_setprio(0); } while (0)
#define PG8_WAIT_V(n) asm volatile("s_waitcnt vmcnt(" #n ")" ::: "memory")
#define PG8_WAIT_L(n) asm volatile("s_waitcnt lgkmcnt(" #n ")" ::: "memory")
#define PG8_BAR __builtin_amdgcn_s_barrier()
#define PG8_SCHED __builtin_amdgcn_sched_barrier(0)
    Unit cur, nxt; int ui = 0;
    if (!S.next(0, cur)) return;
    f32x4 acc[2][2][4][2];
#pragma unroll
    for (int a = 0; a < 2; ++a)
#pragma unroll
        for (int b = 0; b < 2; ++b)
#pragma unroll
            for (int m = 0; m < 4; ++m)
#pragma unroll
                for (int n = 0; n < 2; ++n) acc[a][b][m][n] = (f32x4){0.f, 0.f, 0.f, 0.f};
    bf16x8 At[4][2], B0[2][2], B1[2][2];
    const char* cA = (const char*)g.A + (size_t)cur.pm * tstep; const char* cB = (const char*)g.Bt + (size_t)cur.pn * tstep;
    S.a_ready(cur);
    if constexpr (SP2) {
        PG8_STAGE(PG8_SB(0, 0), cB, voffB); PG8_STAGE(PG8_SB(0, 1), cB + hstep, voffB); PG8_STAGE(PG8_SA(0, 0), cA, voffA); PG8_STAGE(PG8_SA(0, 1), cA + hstep, voffA);
        if (wr == 1) PG8_BAR;
        PG8_WAIT_V(2); PG8_BAR;
        PG8_STAGE(PG8_SB(1, 0), cB + kstep, voffB); PG8_STAGE(PG8_SA(1, 0), cA + kstep, voffA); PG8_STAGE(PG8_SB(1, 1), cB + hstep + kstep, voffB);
        PG8_WAIT_V(6); PG8_BAR;
    } else {
        PG8_STAGE(PG8_SB(0, 0), cB, voffB); PG8_STAGE(PG8_SA(0, 0), cA, voffA); PG8_STAGE(PG8_SB(0, 1), cB + hstep, voffB); PG8_STAGE(PG8_SA(0, 1), cA + hstep, voffA);
        if (wr == 1) PG8_BAR;
        PG8_WAIT_V(4); PG8_BAR;
        PG8_STAGE(PG8_SB(1, 0), cB + kstep, voffB); PG8_STAGE(PG8_SA(1, 0), cA + kstep, voffA); PG8_STAGE(PG8_SB(1, 1), cB + hstep + kstep, voffB);
        PG8_WAIT_V(6); PG8_BAR;
    }
    for (;;) {
        const bool has_next = S.next(ui + 1, nxt);
        const char* nA = has_next ? (const char*)g.A + (size_t)nxt.pm * tstep : cA; const char* nB = has_next ? (const char*)g.Bt + (size_t)nxt.pn * tstep : cB;
        for (int t = 0; t < nt; t += 2) {
            const bool last = (t == nt - 2);
            const char* a1 = cA + (size_t)(t + 1) * kstep;
            const char* a2 = last ? nA : cA + (size_t)(t + 2) * kstep; const char* b2 = last ? nB : cB + (size_t)(t + 2) * kstep;
            const char* a3 = a2 + kstep; const char* b3 = b2 + kstep;
            if (last && has_next) S.a_ready(nxt);
            if constexpr (SP2) {
            PG8_LDB(B0, 0, 0); PG8_LDB(B1, 0, 1); PG8_SCHED; PG8_LDA(At, 0, 0); PG8_STAGE(PG8_SA(1, 1), a1 + hstep, voffA);
            PG8_WAIT_V(8); PG8_WAIT_L(0); PG8_BAR; PG8_MMA(0, 0, At, B0); PG8_MMA(0, 1, At, B1); PG8_BAR; PG8_SCHED;
            PG8_LDA(At, 0, 1); PG8_STAGE(PG8_SB(0, 0), b2, voffB); PG8_STAGE(PG8_SB(0, 1), b2 + hstep, voffB); PG8_STAGE(PG8_SA(0, 0), a2, voffA);
            PG8_WAIT_V(8); PG8_WAIT_L(0); PG8_BAR; PG8_MMA(1, 0, At, B0); PG8_MMA(1, 1, At, B1); PG8_BAR; PG8_SCHED;
            PG8_LDB(B0, 1, 0); PG8_LDB(B1, 1, 1); PG8_SCHED; PG8_LDA(At, 1, 0); PG8_STAGE(PG8_SA(0, 1), a2 + hstep, voffA);
            PG8_WAIT_V(8); PG8_WAIT_L(0); PG8_BAR; PG8_MMA(0, 0, At, B0); PG8_MMA(0, 1, At, B1); PG8_BAR; PG8_SCHED;
            PG8_LDA(At, 1, 1); PG8_STAGE(PG8_SB(1, 0), b3, voffB); PG8_STAGE(PG8_SB(1, 1), b3 + hstep, voffB); PG8_STAGE(PG8_SA(1, 0), a3, voffA);
            PG8_WAIT_V(8); PG8_WAIT_L(0); PG8_BAR; PG8_MMA(1, 0, At, B0); PG8_MMA(1, 1, At, B1); PG8_BAR; PG8_SCHED;
            } else {
            PG8_LDB(B0, 0, 0); PG8_SCHED; PG8_LDA(At, 0, 0); PG8_STAGE(PG8_SA(1, 1), a1 + hstep, voffA);
            PG8_WAIT_L(8); PG8_BAR; PG8_WAIT_L(0); PG8_MMA(0, 0, At, B0); PG8_BAR; PG8_SCHED;
            PG8_LDB(B1, 0, 1); PG8_STAGE(PG8_SB(0, 0), b2, voffB);
            PG8_BAR; PG8_WAIT_L(0); PG8_MMA(0, 1, At, B1); PG8_BAR;
            PG8_LDA(At, 0, 1); PG8_STAGE(PG8_SA(0, 0), a2, voffA);
            PG8_BAR; PG8_WAIT_L(0); PG8_MMA(1, 0, At, B0); PG8_BAR; PG8_SCHED;
            PG8_STAGE(PG8_SB(0, 1), b2 + hstep, voffB);
            PG8_WAIT_V(6); PG8_BAR; PG8_MMA(1, 1, At, B1); PG8_BAR;
            PG8_LDB(B0, 1, 0); PG8_SCHED; PG8_LDA(At, 1, 0); PG8_STAGE(PG8_SA(0, 1), a2 + hstep, voffA);
            PG8_WAIT_L(8); PG8_BAR; PG8_WAIT_L(0); PG8_MMA(0, 0, At, B0); PG8_BAR; PG8_SCHED;
            PG8_LDB(B1, 1, 1); PG8_STAGE(PG8_SB(1, 0), b3, voffB);
            PG8_BAR; PG8_WAIT_L(0); PG8_MMA(0, 1, At, B1); PG8_BAR;
            PG8_LDA(At, 1, 1); PG8_STAGE(PG8_SA(1, 0), a3, voffA);
            PG8_BAR; PG8_WAIT_L(0); PG8_MMA(1, 0, At, B0); PG8_BAR; PG8_SCHED;
            PG8_STAGE(PG8_SB(1, 1), b3 + hstep, voffB);
            PG8_WAIT_V(6); PG8_BAR; PG8_MMA(1, 1, At, B1); PG8_BAR;
            }
        }
        if constexpr (ALIGN_EPI) { if (wr == 0) PG8_BAR; }
        if constexpr (!Epi::AFTER_DRAIN) { E(acc, cur, wr, wc, fr, fq); S.done(cur); }
        if (!has_next) break;
#pragma unroll
        for (int a = 0; a < 2; ++a)
#pragma unroll
            for (int b = 0; b < 2; ++b)
#pragma unroll
                for (int m = 0; m < 4; ++m)
#pragma unroll
                    for (int n = 0; n < 2; ++n) acc[a][b][m][n] = (f32x4){0.f, 0.f, 0.f, 0.f};
        cur = nxt; cA = nA; cB = nB; ++ui;
        if constexpr (ALIGN_EPI) { if (wr == 1) PG8_BAR; }
    }
    PG8_WAIT_V(0);
    if constexpr (!ALIGN_EPI) { if (wr == 0) PG8_BAR; }
    PG8_BAR;
    if constexpr (Epi::AFTER_DRAIN) { E.fused(acc, cur, wr, wc, fr, fq, lds, wid, lane); S.done(cur); }
#undef PG8_SA
#undef PG8_SB
#undef PG8_STAGE
#undef PG8_LDA
#undef PG8_LDB
#undef PG8_MMA
#undef PG8_WAIT_V
#undef PG8_WAIT_L
#undef PG8_BAR
#undef PG8_SCHED
}
}

namespace cg = cooperative_groups;
#define LAS __attribute__((address_space(3)))
using pg8::bf16_t; using pg8::bf16x8; using pg8::f32x4; using pg8::u32x4;
typedef float f32x16 __attribute__((ext_vector_type(16)));
typedef unsigned u32x2 __attribute__((ext_vector_type(2)));

constexpr int NWAVES = 8;
constexpr int D = 1024, BATCH = 4, SEQ = 8192, TOK = BATCH * SEQ, MEML = 256, INW = 6656, FFH = 2816;
constexpr float LN_EPS = 1e-5f;
constexpr size_t MiB = 1u << 20;
constexpr size_t WS_COS = 1 * MiB, WS_SIN = 3 * MiB, WS_COST = 5 * MiB, WS_SINT = 7 * MiB;
constexpr size_t WS_MEMB = 9 * MiB, WS_MEMK = 11 * MiB, WS_MEMVT = 13 * MiB;
constexpr size_t W_SBQK = 16 * MiB, W_SBV = 18 * MiB, W_RQK = 19 * MiB, W_RV = 21 * MiB, W_RG = 23 * MiB, W_GATE = 25 * MiB, W_SBO = 29 * MiB, W_RETO = 30 * MiB,
                 W_MIXO = 32 * MiB, W_MEMQ = 34 * MiB, W_MEMKV = 36 * MiB, W_MEMO = 40 * MiB, W_FFNI = 42 * MiB, W_FFNO = 53 * MiB;
constexpr size_t WS_XB = 60 * MiB, WS_SBQ = 124 * MiB, WS_SBK = 156 * MiB, WS_SBVT = 188 * MiB, WS_RQ = 220 * MiB, WS_RK = 252 * MiB, WS_RKT = 284 * MiB,
                 WS_RVT = 316 * MiB, WS_RG = 380 * MiB, WS_ST = 444 * MiB, WS_END = 508 * MiB;
constexpr size_t WS_YSB = 220 * MiB, WS_YRET = 284 * MiB, WS_MIXIN = 156 * MiB, WS_QM = 220 * MiB, WS_HID = 284 * MiB;
constexpr int LDS_BYTES = 147456;

__constant__ float INVF[64] = {1.000000000e+00f, 8.659643531e-01f, 7.498942018e-01f, 6.493816376e-01f, 5.623413324e-01f, 4.869675338e-01f, 4.216965139e-01f, 3.651741147e-01f, 3.162277639e-01f, 2.738419771e-01f, 2.371373922e-01f, 2.053525001e-01f, 1.778279394e-01f, 1.539926529e-01f, 1.333521456e-01f, 1.154782027e-01f, 1.000000015e-01f, 8.659642935e-02f, 7.498941571e-02f, 6.493816525e-02f, 5.623412877e-02f, 4.869675264e-02f, 4.216964915e-02f, 3.651741147e-02f, 3.162277862e-02f, 2.738419734e-02f, 2.371373586e-02f, 2.053524926e-02f, 1.778279431e-02f, 1.539926510e-02f, 1.333521493e-02f, 1.154781971e-02f, 9.999999776e-03f, 8.659643121e-03f, 7.498942316e-03f, 6.493816618e-03f, 5.623413250e-03f, 4.869675264e-03f, 4.216964822e-03f, 3.651741426e-03f, 3.162277862e-03f, 2.738419687e-03f, 2.371373819e-03f, 2.053525066e-03f, 1.778279431e-03f, 1.539926627e-03f, 1.333521446e-03f, 1.154781901e-03f, 1.000000047e-03f, 8.659643354e-04f, 7.498941850e-04f, 6.493816618e-04f, 5.623413017e-04f, 4.869675031e-04f, 4.216965463e-04f, 3.651741135e-04f, 3.162277862e-04f, 2.738419571e-04f, 2.371373848e-04f, 2.053525241e-04f, 1.778279402e-04f, 1.539926452e-04f, 1.333521504e-04f, 1.154782076e-04f};

__device__ __forceinline__ f32x16 mfma32(bf16x8 a, bf16x8 b, f32x16 c) { return __builtin_amdgcn_mfma_f32_32x32x16_bf16(a, b, c, 0, 0, 0); }
__device__ __forceinline__ f32x4 mfma16(bf16x8 a, bf16x8 b, f32x4 c) { return __builtin_amdgcn_mfma_f32_16x16x32_bf16(a, b, c, 0, 0, 0); }
__device__ __forceinline__ unsigned pk2(float lo, float hi) { return pg8::cvt_pk_bf16(lo, hi); }
__device__ __forceinline__ float bf_lo(unsigned w) { return __uint_as_float(w << 16); }
__device__ __forceinline__ float bf_hi(unsigned w) { return __uint_as_float(w & 0xffff0000u); }
__device__ __forceinline__ float wave_sum(float v) {
#pragma unroll
    for (int o = 1; o < 64; o <<= 1) v += __shfl_xor(v, o);
    return v;
}

__device__ __forceinline__ int map_row(int mode, int n0) {
    if (mode == 0) return n0;
    if (mode == 1) { const int which = n0 >> 9, hd = n0 & 511, head = hd >> 7, a = (hd >> 6) & 1, i = hd & 63; return which * 512 + (head >> 1) * 256 + a * 128 + (head & 1) * 64 + i; }
    if (mode == 2) { const int br = n0 >> 10, ch = n0 & 1023; return (ch >> 7) * 256 + br * 128 + (ch & 127); }
    const int br = n0 / FFH, hc = n0 % FFH; return (hc >> 7) * 256 + br * 128 + (hc & 127);
}
__device__ __forceinline__ void p0_transpose_item(const float* W, int K, int ldw, int col0, int nblk, bf16_t* WT, int mode, LAS float* scr, int item, int lane) {
    const int kb = item / nblk, nb = item % nblk, k0 = 64 * kb, n0 = 32 * nb;
#pragma unroll 8
    for (int i = 0; i < 32; ++i) { const int kk = 2 * i + (lane >> 5); scr[kk * 33 + (lane & 31)] = W[(size_t)(k0 + kk) * ldw + col0 + n0 + (lane & 31)]; }
    asm volatile("s_waitcnt lgkmcnt(0)" ::: "memory");
    const int c = lane & 7, r0 = map_row(mode, n0);
#pragma unroll
    for (int j = 0; j < 4; ++j) { const int n = (lane >> 3) + 8 * j; const LAS float* s = scr + (8 * c) * 33 + n;
        u32x4 o; o.x = pk2(s[0 * 33], s[1 * 33]); o.y = pk2(s[2 * 33], s[3 * 33]); o.z = pk2(s[4 * 33], s[5 * 33]); o.w = pk2(s[6 * 33], s[7 * 33]);
        *(u32x4*)(WT + (size_t)(r0 + n) * K + k0 + 8 * c) = o; }
    asm volatile("s_waitcnt lgkmcnt(0)" ::: "memory");
}

struct Args { const float* in[18]; float* out; unsigned char* ws; };

__device__ __forceinline__ void p0_prologue(const Args& A, LAS unsigned char* lds, int gw, int NGW, int wave, int lane) {
    LAS float* scr = (LAS float*)(lds + wave * 16384);
    unsigned char* ws = A.ws;
    const float* w_in = A.in[2];
    {
        constexpr int I0 = 16 * 32, I1 = I0 + 16 * 16, I2 = I1 + 16 * 32, I3 = I2 + 16 * 32, I4 = I3 + 16 * 32, I5 = I4 + 16 * 64, I6 = I5 + 8 * 32, I7 = I6 + 16 * 32, I8 = I7 + 16 * 32, I9 = I8 + 16 * 32,
                      I10 = I9 + 16 * 64, I11 = I10 + 16 * 32, I12 = I11 + 16 * 176, I13 = I12 + 44 * 32;
        for (int it0 = gw; it0 < I13; it0 += NGW) {
            const float* W; int K = D, ldw = D, col0 = 0, nblk = 32, mode = 0, it; size_t dst;
            if (it0 < I0) { W = w_in; ldw = INW; dst = W_SBQK; it = it0; }
            else if (it0 < I1) { W = w_in; ldw = INW; col0 = 1024; nblk = 16; dst = W_SBV; it = it0 - I0; }
            else if (it0 < I2) { W = w_in; ldw = INW; col0 = 1536; mode = 1; dst = W_RQK; it = it0 - I1; }
            else if (it0 < I3) { W = w_in; ldw = INW; col0 = 2560; dst = W_RV; it = it0 - I2; }
            else if (it0 < I4) { W = w_in; ldw = INW; col0 = 3584; dst = W_RG; it = it0 - I3; }
            else if (it0 < I5) { W = w_in; ldw = INW; col0 = 4608; nblk = 64; mode = 2; dst = W_GATE; it = it0 - I4; }
            else if (it0 < I6) { W = A.in[4]; K = 512; dst = W_SBO; it = it0 - I5; }
            else if (it0 < I7) { W = A.in[5]; dst = W_RETO; it = it0 - I6; }
            else if (it0 < I8) { W = A.in[6]; dst = W_MIXO; it = it0 - I7; }
            else if (it0 < I9) { W = A.in[9]; dst = W_MEMQ; it = it0 - I8; }
            else if (it0 < I10) { W = A.in[10]; ldw = 2 * D; nblk = 64; dst = W_MEMKV; it = it0 - I9; }
            else if (it0 < I11) { W = A.in[11]; dst = W_MEMO; it = it0 - I10; }
            else if (it0 < I12) { W = A.in[14]; ldw = 2 * FFH; nblk = 176; mode = 3; dst = W_FFNI; it = it0 - I11; }
            else { W = A.in[15]; K = FFH; dst = W_FFNO; it = it0 - I12; }
            p0_transpose_item(W, K, ldw, col0, nblk, (bf16_t*)(ws + dst), mode, scr, it, lane);
        }
    }
    {
        const size_t gt = (size_t)gw * 64 + lane, NT = (size_t)NGW * 64;
        const float* x = A.in[0]; bf16_t* xb = (bf16_t*)(ws + WS_XB);
        for (size_t e = gt; e < (size_t)TOK * D / 8; e += NT) { const f32x4 a = *(const f32x4*)(x + e * 8), b = *(const f32x4*)(x + e * 8 + 4); *(u32x4*)(xb + e * 8) = pg8::pack8(a, b); }
        const float* mem = A.in[1]; bf16_t* mb = (bf16_t*)(ws + WS_MEMB);
        for (size_t e = gt; e < (size_t)BATCH * MEML * D / 8; e += NT) { const f32x4 a = *(const f32x4*)(mem + e * 8), b = *(const f32x4*)(mem + e * 8 + 4); *(u32x4*)(mb + e * 8) = pg8::pack8(a, b); }
        float* ct = (float*)(ws + WS_COS); float* st = (float*)(ws + WS_SIN); float* ctt = (float*)(ws + WS_COST); float* stt = (float*)(ws + WS_SINT);
        for (size_t e = gt; e < (size_t)SEQ * 64; e += NT) { const int pos = (int)(e >> 6), i = (int)(e & 63);
            const float ang = (float)pos * INVF[i]; const double rev = (double)ang * 0.15915494309189535; const float fr = (float)(rev - __builtin_floor(rev));
            const float s = __builtin_amdgcn_sinf(fr), c = __builtin_amdgcn_cosf(fr);
            ct[e] = c; st[e] = s; ctt[(size_t)i * SEQ + pos] = c; stt[(size_t)i * SEQ + pos] = s; }
    }
}

__device__ __forceinline__ void sb_unit(const bf16_t* Q, const bf16_t* K, const bf16_t* VT, bf16_t* O, int b, int h, int qb, int lane) {
    const int q = lane & 31, hi = lane >> 5;
    const size_t rowbase = (size_t)b * SEQ;
    const int q0 = qb * 32, tq = q0 + q;
    const bf16_t* qp = Q + (rowbase + q0 + q) * 512 + h * 64 + 8 * hi;
    bf16x8 qf[4];
#pragma unroll
    for (int ks = 0; ks < 4; ++ks) qf[ks] = *(const bf16x8*)(qp + 16 * ks);
    f32x16 o0 = {}, o1 = {};
    float R = 0.f;
    const int kperm = 16 * ((q >> 2) & 1) + (q & 3) + 4 * (q >> 3);
    const bf16_t* kp = K + (rowbase + kperm) * 512 + h * 64 + 8 * hi;
    const bf16_t* vp = VT + (size_t)(h * 64 + q) * TOK + rowbase + 16 * hi;
    for (int kt = qb; kt >= 0; --kt) {
        const int k0 = kt * 32;
        bf16x8 kf[4];
#pragma unroll
        for (int ks = 0; ks < 4; ++ks) kf[ks] = *(const bf16x8*)(kp + (size_t)k0 * 512 + 16 * ks);
        bf16x8 vf[2][2];
#pragma unroll
        for (int j = 0; j < 2; ++j)
#pragma unroll
            for (int db = 0; db < 2; ++db) vf[j][db] = *(const bf16x8*)(vp + (size_t)(32 * db) * TOK + k0 + 8 * j);
        f32x16 s = {};
#pragma unroll
        for (int ks = 0; ks < 4; ++ks) s = mfma32(kf[ks], qf[ks], s);
        const int key0 = k0 + 16 * hi;
        float lb[16], lr[16]; float tot = 0.f;
#pragma unroll
        for (int r = 0; r < 16; ++r) { const float z = s[r] * 0.125f; const float a = pg8::ex2(-__builtin_fabsf(z) * 1.4426950408889634f);
            const float l = __builtin_amdgcn_logf(1.f + a) * 0.6931471805599453f; const float sp = __builtin_fmaxf(z, 0.f) + l;
            lb[r] = z - sp;
            lr[r] = (key0 + r < tq) ? -sp : 0.f; tot += lr[r]; }
        const float tot_o = __shfl_xor(tot, 32);
        float run = R + (hi == 0 ? tot_o : 0.f);
        float w[16];
#pragma unroll
        for (int r = 15; r >= 0; --r) { w[r] = (key0 + r < tq) ? pg8::fexp(lb[r] + run) : 0.f; run += lr[r]; }
        R += tot + tot_o;
        u32x4 p0, p1;
        p0.x = pk2(w[0], w[1]); p0.y = pk2(w[2], w[3]); p0.z = pk2(w[4], w[5]); p0.w = pk2(w[6], w[7]);
        p1.x = pk2(w[8], w[9]); p1.y = pk2(w[10], w[11]); p1.z = pk2(w[12], w[13]); p1.w = pk2(w[14], w[15]);
        const bf16x8 pf0 = __builtin_bit_cast(bf16x8, p0), pf1 = __builtin_bit_cast(bf16x8, p1);
        o0 = mfma32(vf[0][0], pf0, o0); o1 = mfma32(vf[0][1], pf0, o1);
        o0 = mfma32(vf[1][0], pf1, o0); o1 = mfma32(vf[1][1], pf1, o1);
        if (__all(R < -120.f)) break;
    }
    bf16_t* op = O + (rowbase + q0 + q) * 512 + h * 64 + 4 * hi;
#pragma unroll
    for (int g = 0; g < 4; ++g) {
        u32x2 a; a.x = pk2(o0[4 * g], o0[4 * g + 1]); a.y = pk2(o0[4 * g + 2], o0[4 * g + 3]); *(u32x2*)(op + 8 * g) = a;
        u32x2 c; c.x = pk2(o1[4 * g], o1[4 * g + 1]); c.y = pk2(o1[4 * g + 2], o1[4 * g + 3]); *(u32x2*)(op + 32 + 8 * g) = c;
    }
}

__device__ __forceinline__ float lg2_gamma(int h) { return h == 0 ? -0.04580368961312479f : h == 1 ? -0.02272007650008353f : h == 2 ? -0.011315313227834146f : -0.005646563141142063f; }
__device__ __forceinline__ void ret_kv_unit(const bf16_t* RKT, const bf16_t* RVT, bf16_t* ST, int bh, int n, int dvb, int lane) {
    const int b = bh >> 2, h = bh & 3, c = lane & 31, hi = lane >> 5;
    const size_t tok0 = (size_t)b * SEQ + (size_t)n * 128;
    const float lg = lg2_gamma(h);
    f32x16 acc[4] = {};
    const bf16_t* kp = RKT + (size_t)(h * 128 + c) * TOK + tok0 + 8 * hi;
    const bf16_t* vp = RVT + (size_t)(h * 256 + dvb * 32 + c) * TOK + tok0 + 8 * hi;
#pragma unroll
    for (int ks = 0; ks < 8; ++ks) {
        const u32x4 vr = *(const u32x4*)(vp + 16 * ks);
        const int j0 = 16 * ks + 8 * hi;
        u32x4 vd;
        vd.x = pk2(bf_lo(vr.x) * pg8::ex2(lg * (float)(127 - j0)), bf_hi(vr.x) * pg8::ex2(lg * (float)(126 - j0)));
        vd.y = pk2(bf_lo(vr.y) * pg8::ex2(lg * (float)(125 - j0)), bf_hi(vr.y) * pg8::ex2(lg * (float)(124 - j0)));
        vd.z = pk2(bf_lo(vr.z) * pg8::ex2(lg * (float)(123 - j0)), bf_hi(vr.z) * pg8::ex2(lg * (float)(122 - j0)));
        vd.w = pk2(bf_lo(vr.w) * pg8::ex2(lg * (float)(121 - j0)), bf_hi(vr.w) * pg8::ex2(lg * (float)(120 - j0)));
        const bf16x8 vf = __builtin_bit_cast(bf16x8, vd);
#pragma unroll
        for (int kb = 0; kb < 4; ++kb) { const bf16x8 kf = *(const bf16x8*)(kp + (size_t)(32 * kb) * TOK + 16 * ks); acc[kb] = mfma32(kf, vf, acc[kb]); }
    }
    bf16_t* sp = ST + ((size_t)(bh * 64 + n) * 256 + dvb * 32 + c) * 128 + 4 * hi;
#pragma unroll
    for (int kb = 0; kb < 4; ++kb)
#pragma unroll
        for (int g = 0; g < 4; ++g) { u32x2 a; a.x = pk2(acc[kb][4 * g], acc[kb][4 * g + 1]); a.y = pk2(acc[kb][4 * g + 2], acc[kb][4 * g + 3]); *(u32x2*)(sp + 32 * kb + 8 * g) = a; }
}
__device__ __forceinline__ void ret_scan(bf16_t* ST, size_t gt, size_t NT) {
    for (size_t e = gt; e < (size_t)16 * 8192; e += NT) {
        const int bh = (int)(e >> 13); const size_t off = (e & 8191) * 4;
        const float cd = pg8::ex2(lg2_gamma(bh & 3) * 128.f);
        bf16_t* p = ST + (size_t)bh * 64 * 32768 + off;
        float s0 = 0.f, s1 = 0.f, s2 = 0.f, s3 = 0.f;
#pragma unroll 8
        for (int n = 0; n < 64; ++n) { const u32x2 kv = *(const u32x2*)(p + (size_t)n * 32768);
            u32x2 o; o.x = pk2(s0, s1); o.y = pk2(s2, s3); *(u32x2*)(p + (size_t)n * 32768) = o;
            s0 = s0 * cd + bf_lo(kv.x); s1 = s1 * cd + bf_hi(kv.x); s2 = s2 * cd + bf_lo(kv.y); s3 = s3 * cd + bf_hi(kv.y); }
    }
}
__device__ __forceinline__ void ret_out_unit(const bf16_t* RQ, const bf16_t* RK, const bf16_t* RVT, const bf16_t* ST, const bf16_t* RG, bf16_t* OUT, int bh, int n, int rb, int lane) {
    const int b = bh >> 2, h = bh & 3, i = lane & 15, g = lane >> 4;
    const size_t tok0 = (size_t)b * SEQ + (size_t)n * 128;
    const int row = 16 * rb + i;
    const float lg = lg2_gamma(h);
    bf16x8 qf[4];
    const bf16_t* qp = RQ + (tok0 + row) * 512 + h * 128 + 8 * g;
#pragma unroll
    for (int ks = 0; ks < 4; ++ks) qf[ks] = *(const bf16x8*)(qp + 32 * ks);
    f32x4 acc[16];
    const bf16_t* sp = ST + ((size_t)(bh * 64 + n) * 256 + i) * 128 + 8 * g;
#pragma unroll
    for (int db = 0; db < 16; ++db) { f32x4 a = {0.f, 0.f, 0.f, 0.f};
#pragma unroll
        for (int ks = 0; ks < 4; ++ks) { const bf16x8 sf = *(const bf16x8*)(sp + (size_t)(16 * db) * 128 + 32 * ks); a = mfma16(sf, qf[ks], a); }
        acc[db] = a; }
    const float qd = pg8::ex2(lg * (float)(row + 1));
#pragma unroll
    for (int db = 0; db < 16; ++db) acc[db] = acc[db] * qd;
    const bf16_t* kp = RK + (tok0 + 8 * (i >> 2) + (i & 3)) * 512 + h * 128 + 8 * g;
    const bf16_t* vp = RVT + (size_t)(h * 256 + i) * TOK + tok0 + 8 * g;
    const int ns = (rb >> 1) + 1;
    for (int s = 0; s < ns; ++s) {
        f32x4 c0 = {0.f, 0.f, 0.f, 0.f}, c1 = {0.f, 0.f, 0.f, 0.f};
#pragma unroll
        for (int ks = 0; ks < 4; ++ks) { const bf16x8 k0 = *(const bf16x8*)(kp + (size_t)(32 * s) * 512 + 32 * ks), k1 = *(const bf16x8*)(kp + (size_t)(32 * s + 4) * 512 + 32 * ks);
            c0 = mfma16(k0, qf[ks], c0); c1 = mfma16(k1, qf[ks], c1); }
        const int j0 = 32 * s + 8 * g;
        float p[8];
#pragma unroll
        for (int e = 0; e < 4; ++e) { const int ja = j0 + e, jb = j0 + 4 + e;
            p[e] = (ja <= row) ? c0[e] * pg8::ex2(lg * (float)(row - ja)) : 0.f; p[4 + e] = (jb <= row) ? c1[e] * pg8::ex2(lg * (float)(row - jb)) : 0.f; }
        u32x4 pw; pw.x = pk2(p[0], p[1]); pw.y = pk2(p[2], p[3]); pw.z = pk2(p[4], p[5]); pw.w = pk2(p[6], p[7]);
        const bf16x8 pf = __builtin_bit_cast(bf16x8, pw);
#pragma unroll
        for (int db = 0; db < 16; ++db) { const bf16x8 vf = *(const bf16x8*)(vp + (size_t)(16 * db) * TOK + 32 * s); acc[db] = mfma16(vf, pf, acc[db]); }
    }
    float sum = 0.f;
#pragma unroll
    for (int db = 0; db < 16; ++db) sum += (acc[db][0] + acc[db][1]) + (acc[db][2] + acc[db][3]);
    sum += __shfl_xor(sum, 16); sum += __shfl_xor(sum, 32);
    const float mean = sum * (1.f / 256.f); float sq = 0.f;
#pragma unroll
    for (int db = 0; db < 16; ++db) { const f32x4 d = acc[db] - mean; sq += (d[0] * d[0] + d[1] * d[1]) + (d[2] * d[2] + d[3] * d[3]); }
    sq += __shfl_xor(sq, 16); sq += __shfl_xor(sq, 32);
    const float rstd = 1.f / __builtin_sqrtf(sq * (1.f / 256.f) + LN_EPS);
    const bf16_t* gp = RG + (tok0 + row) * 1024 + h * 256 + 4 * g; bf16_t* outp = OUT + (tok0 + row) * 1024 + h * 256 + 4 * g;
#pragma unroll
    for (int db = 0; db < 16; ++db) { const u32x2 gv = *(const u32x2*)(gp + 16 * db); const f32x4 d = (acc[db] - mean) * rstd;
        u32x2 o; o.x = pk2(d[0] * bf_lo(gv.x), d[1] * bf_hi(gv.x)); o.y = pk2(d[2] * bf_lo(gv.y), d[3] * bf_hi(gv.y)); *(u32x2*)(outp + 16 * db) = o; }
}

__device__ __forceinline__ void xattn_unit(const bf16_t* QM, const bf16_t* MK, const bf16_t* MVT, bf16_t* AO, int b, int mh, int rblk, int lane) {
    const int i = lane & 15, g = lane >> 4;
    const size_t row = (size_t)b * SEQ + (size_t)rblk * 16 + i;
    const bf16_t* qp = QM + row * 1024 + mh * 256 + 8 * g;
    bf16x8 qf[8];
#pragma unroll
    for (int ks = 0; ks < 8; ++ks) qf[ks] = *(const bf16x8*)(qp + 32 * ks);
    f32x4 c[16];
    const bf16_t* kp = MK + ((size_t)b * MEML + 8 * (i >> 2) + (i & 3)) * 1024 + mh * 256 + 8 * g;
#pragma unroll
    for (int mb = 0; mb < 16; ++mb) { f32x4 a = {0.f, 0.f, 0.f, 0.f};
#pragma unroll
        for (int ks = 0; ks < 8; ++ks) { const bf16x8 kf = *(const bf16x8*)(kp + (size_t)(32 * (mb >> 1) + 4 * (mb & 1)) * 1024 + 32 * ks); a = mfma16(kf, qf[ks], a); }
        c[mb] = a; }
    float mx = -3.0e38f;
#pragma unroll
    for (int mb = 0; mb < 16; ++mb) mx = __builtin_fmaxf(mx, __builtin_fmaxf(__builtin_fmaxf(c[mb][0], c[mb][1]), __builtin_fmaxf(c[mb][2], c[mb][3])));
    mx = __builtin_fmaxf(mx, __shfl_xor(mx, 16)); mx = __builtin_fmaxf(mx, __shfl_xor(mx, 32));
    const float sc = 0.0625f * 1.4426950408889634f; float sum = 0.f;
#pragma unroll
    for (int mb = 0; mb < 16; ++mb)
#pragma unroll
        for (int e = 0; e < 4; ++e) { const float p = pg8::ex2((c[mb][e] - mx) * sc); c[mb][e] = p; sum += p; }
    sum += __shfl_xor(sum, 16); sum += __shfl_xor(sum, 32);
    const float rs = 1.f / sum;
    bf16x8 pf[8];
#pragma unroll
    for (int s = 0; s < 8; ++s) { u32x4 w; w.x = pk2(c[2 * s][0], c[2 * s][1]); w.y = pk2(c[2 * s][2], c[2 * s][3]); w.z = pk2(c[2 * s + 1][0], c[2 * s + 1][1]); w.w = pk2(c[2 * s + 1][2], c[2 * s + 1][3]); pf[s] = __builtin_bit_cast(bf16x8, w); }
    const bf16_t* vp = MVT + (size_t)(mh * 256 + i) * 1024 + b * MEML + 8 * g;
    bf16_t* op = AO + row * 1024 + mh * 256 + 4 * g;
#pragma unroll
    for (int db = 0; db < 16; ++db) { f32x4 o = {0.f, 0.f, 0.f, 0.f};
#pragma unroll
        for (int s = 0; s < 8; ++s) { const bf16x8 vf = *(const bf16x8*)(vp + (size_t)(16 * db) * 1024 + 32 * s); o = mfma16(vf, pf[s], o); }
        o = o * rs; u32x2 w; w.x = pk2(o[0], o[1]); w.y = pk2(o[2], o[3]); *(u32x2*)(op + 16 * db) = w; }
}

__device__ __forceinline__ void ln_pass(float* io, const float* gam, const float* bet, bf16_t* ob, int gw, int NGW, int lane) {
    f32x4 gv[4], bv[4];
#pragma unroll
    for (int j = 0; j < 4; ++j) { gv[j] = *(const f32x4*)(gam + 4 * lane + 256 * j); bv[j] = *(const f32x4*)(bet + 4 * lane + 256 * j); }
    for (int m = gw; m < TOK; m += NGW) {
        float* xr = io + (size_t)m * D + 4 * lane;
        f32x4 v[4]; float s = 0.f;
#pragma unroll
        for (int j = 0; j < 4; ++j) { v[j] = *(const f32x4*)(xr + 256 * j); s += (v[j][0] + v[j][1]) + (v[j][2] + v[j][3]); }
        const float mean = wave_sum(s) * (1.f / D); float s2 = 0.f;
#pragma unroll
        for (int j = 0; j < 4; ++j) { v[j] = v[j] - mean; s2 += (v[j][0] * v[j][0] + v[j][1] * v[j][1]) + (v[j][2] * v[j][2] + v[j][3] * v[j][3]); }
        const float rstd = 1.f / __builtin_sqrtf(wave_sum(s2) * (1.f / D) + LN_EPS);
#pragma unroll
        for (int j = 0; j < 4; ++j) { const f32x4 y = v[j] * rstd * gv[j] + bv[j]; *(f32x4*)(xr + 256 * j) = y;
            if (ob) { u32x2 w; w.x = pk2(y[0], y[1]); w.y = pk2(y[2], y[3]); *(u32x2*)(ob + (size_t)m * D + 4 * lane + 256 * j) = w; } }
    }
}

#define RLX_AGENT __ATOMIC_RELAXED, __HIP_MEMORY_SCOPE_AGENT
#define LDS_WAIT() asm volatile("s_waitcnt lgkmcnt(0)" ::: "memory")
#define VM_WAIT() asm volatile("s_waitcnt vmcnt(0)" ::: "memory")
__device__ __forceinline__ unsigned long long rt() { return __builtin_amdgcn_s_memrealtime(); }
#define XB_TMO      128
#define XB_XCNT(j)  (256  + 64 * (j))
#define XB_XSUB(j)  (1280 + 64 * (j))
#define XB_XGEN(j)  (2304 + 64 * (j))
#define XB_TOP      3328
#define XB_TOPGEN   3392
#define XCD_BAR_WORDS 3456
#define XB_SPIN_CAP (1u << 18)

__device__ __forceinline__ unsigned xb_ld(unsigned* p)              { return __hip_atomic_load(p, __ATOMIC_RELAXED, __HIP_MEMORY_SCOPE_AGENT); }
__device__ __forceinline__ unsigned xb_add(unsigned* p, unsigned v) { return __hip_atomic_fetch_add(p, v, __ATOMIC_RELAXED, __HIP_MEMORY_SCOPE_AGENT); }
__device__ __forceinline__ unsigned xb_xcc_id() { return (unsigned)__builtin_amdgcn_s_getreg((3 << 11) | 20) & 0xFu; }
#define XB_SPIN(cond, bar) do { unsigned _sp = 0; while (cond) { __builtin_amdgcn_s_sleep(1); \
    if ((++_sp & 255u) == 0u) { if (xb_ld(&(bar)[XB_TMO])) break; if (_sp > XB_SPIN_CAP) { atomicAdd(&(bar)[XB_TMO], 1u); break; } } } } while (0)

struct XcdBarrier {
    unsigned* bar; unsigned x;
    volatile LAS unsigned* st;
};

__device__ __forceinline__ XcdBarrier xcd_barrier_post(unsigned* bar, volatile LAS unsigned* st) {
    XcdBarrier b; b.bar = bar; b.x = xb_xcc_id(); b.st = st;
    if (threadIdx.x == 0) (void)xb_add(&bar[XB_XCNT(b.x)], 1u);
    return b;
}
__device__ __forceinline__ void xcd_barrier_complete(unsigned* bar, unsigned x, unsigned& nloc, unsigned& nx) {
    const unsigned G = gridDim.x * gridDim.y * gridDim.z;
    unsigned sum, cnt, mine, sp = 0u;
    for (;;) {
        sum = 0u; cnt = 0u; mine = 0u;
#pragma unroll
        for (unsigned j = 0; j < 16; ++j) { const unsigned c = xb_ld(&bar[XB_XCNT(j)]); sum += c; cnt += (c > 0u) ? 1u : 0u; mine = (j == x) ? c : mine; }
        if (sum == G) break;
        __builtin_amdgcn_s_sleep(1);
        if ((++sp & 255u) == 0u) { if (xb_ld(&bar[XB_TMO])) break; if (sp > XB_SPIN_CAP) { atomicAdd(&bar[XB_TMO], 1u); break; } }
    }
    nloc = mine > 0u ? mine : 1u; nx = cnt > 0u ? cnt : 1u;
}

__device__ __forceinline__ void xcd_barrier(const XcdBarrier& b) {
    asm volatile("s_waitcnt vmcnt(0)" ::: "memory");
    __syncthreads();
    if (threadIdx.x == 0) {
        unsigned* bar = b.bar;
        __builtin_amdgcn_s_waitcnt(0);
        unsigned nloc = b.st[0], nx = b.st[1];
        if (nloc == 0u) { xcd_barrier_complete(bar, b.x, nloc, nx); b.st[0] = nloc; b.st[1] = nx; }
        const unsigned old = xb_add(&bar[XB_XSUB(b.x)], 1u);
        const unsigned gen = old / nloc;
        if (old + 1u == (gen + 1u) * nloc) {
            __builtin_amdgcn_fence(__ATOMIC_RELEASE, "agent");
            asm volatile("s_waitcnt vmcnt(0)" ::: "memory");
            const unsigned og = xb_add(&bar[XB_TOP], 1u);
            const unsigned tg = og / nx;
            if (og + 1u == (tg + 1u) * nx) xb_add(&bar[XB_TOPGEN], 1u);
            else XB_SPIN(xb_ld(&bar[XB_TOPGEN]) == tg, bar);
            __builtin_amdgcn_fence(__ATOMIC_ACQUIRE, "agent");
            xb_add(&bar[XB_XGEN(b.x)], 1u);
            asm volatile("s_waitcnt vmcnt(0)" ::: "memory");
        } else {
            XB_SPIN(xb_ld(&bar[XB_XGEN(b.x)]) == gen, bar);
            __builtin_amdgcn_fence(__ATOMIC_ACQUIRE, "agent");
            asm volatile("s_waitcnt vmcnt(0)" ::: "memory");
        }
    }
    __syncthreads();
}

template <int MODE> __device__ __forceinline__ void run_gemm(LAS unsigned char* lds, const bf16_t* A, const bf16_t* Bt, int M, int N, int K, const pg8::EpiArgs& ea) {
    pg8::Gemm g{A, Bt, M, N, K}; pg8::StaticOrder S; S.init(M, N, (int)gridDim.x, (int)blockIdx.x);
    pg8::Epi<MODE> E{ea};
    pg8::gemm_phase<pg8::Epi<MODE>, pg8::StaticOrder, true, true>(lds, g, S, E);
}

__global__ void __launch_bounds__(NWAVES * 64, 2) mega_fwd(Args args) {
    extern __shared__ __attribute__((aligned(16))) unsigned char lds_raw[];
    LAS unsigned char* lds = (LAS unsigned char*)lds_raw;
    cg::grid_group grid = cg::this_grid();
    const int tid = threadIdx.x, lane = tid & 63, wave = __builtin_amdgcn_readfirstlane(tid >> 6);
    const int G = gridDim.x, gw = blockIdx.x * NWAVES + wave, NGW = G * NWAVES;
    unsigned char* ws = args.ws;
    for (int u = tid; u < (LDS_BYTES - 131072) / 4; u += NWAVES * 64) ((LAS unsigned*)(lds + 131072))[u] = 0u;
    __syncthreads();
    const XcdBarrier bar = xcd_barrier_post((unsigned*)ws + 4096, (volatile LAS unsigned*)(lds + 131072 + 320) + 8);
#define WSB(off) ((bf16_t*)(ws + (off)))
#define FRESH_LANE() int ln = lane; asm volatile("" : "+v"(ln))
    bf16_t* XB = WSB(WS_XB);
    const float* cosT = (const float*)(ws + WS_COS); const float* sinT = (const float*)(ws + WS_SIN);
    const float* cosTT = (const float*)(ws + WS_COST); const float* sinTT = (const float*)(ws + WS_SINT);

    { FRESH_LANE(); p0_prologue(args, lds, gw, NGW, wave, ln); }
    grid.sync();

    {
        pg8::EpiArgs e{};
        e = pg8::EpiArgs{}; e.O = WSB(WS_SBQ); e.O2 = WSB(WS_SBK); e.ldc = 512; e.split_pn = 2; e.scale0 = 1.f; e.scale1 = 1.f;
        run_gemm<pg8::EPI_PLAIN>(lds, XB, WSB(W_SBQK), TOK, 1024, D, e);
        e = pg8::EpiArgs{}; e.O = WSB(WS_SBVT); e.ldc = TOK; e.scale0 = 1.f;
        run_gemm<pg8::EPI_PLAIN>(lds, WSB(W_SBV), XB, 512, TOK, D, e);
        e = pg8::EpiArgs{}; e.O = WSB(WS_RQ); e.O2 = WSB(WS_RK); e.ldc = 512; e.scale0 = 0.08838834764831845f; e.scale1 = 1.f; e.f0 = cosT; e.f1 = sinT;
        run_gemm<pg8::EPI_ROT>(lds, XB, WSB(W_RQK), TOK, 1024, D, e);
        e = pg8::EpiArgs{}; e.O = WSB(WS_RKT); e.ldc = TOK; e.f0 = cosTT; e.f1 = sinTT;
        run_gemm<pg8::EPI_ROTT>(lds, WSB(W_RQK) + (size_t)512 * D, XB, 512, TOK, D, e);
        e = pg8::EpiArgs{}; e.O = WSB(WS_RVT); e.ldc = TOK; e.scale0 = 1.f;
        run_gemm<pg8::EPI_PLAIN>(lds, WSB(W_RV), XB, 1024, TOK, D, e);
        e = pg8::EpiArgs{}; e.O = WSB(WS_RG); e.ldc = 1024;
        run_gemm<pg8::EPI_SILU>(lds, XB, WSB(W_RG), TOK, 1024, D, e);
        e = pg8::EpiArgs{}; e.O = WSB(WS_MEMK); e.ldc = 1024; e.scale0 = 1.f;
        run_gemm<pg8::EPI_PLAIN>(lds, WSB(WS_MEMB), WSB(W_MEMKV), BATCH * MEML, 1024, D, e);
        e = pg8::EpiArgs{}; e.O = WSB(WS_MEMVT); e.ldc = BATCH * MEML; e.scale0 = 1.f;
        run_gemm<pg8::EPI_PLAIN>(lds, WSB(W_MEMKV) + (size_t)1024 * D, WSB(WS_MEMB), 1024, BATCH * MEML, D, e);
    }
    xcd_barrier(bar);

    { FRESH_LANE(); for (int u = gw; u < 16 * 64 * 8; u += NGW) ret_kv_unit(WSB(WS_RKT), WSB(WS_RVT), WSB(WS_ST), u >> 9, (u >> 3) & 63, u & 7, ln); }
    { FRESH_LANE(); for (int u = gw; u < BATCH * 8 * 256; u += NGW) sb_unit(WSB(WS_SBQ), WSB(WS_SBK), WSB(WS_SBVT), WSB(WS_SBQ), u >> 11, (u >> 8) & 7, u & 255, ln); }
    xcd_barrier(bar);
    { FRESH_LANE(); ret_scan(WSB(WS_ST), (size_t)gw * 64 + ln, (size_t)NGW * 64); }
    xcd_barrier(bar);
    { FRESH_LANE(); for (int u = gw; u < 16 * 64 * 8; u += NGW) ret_out_unit(WSB(WS_RQ), WSB(WS_RK), WSB(WS_RVT), WSB(WS_ST), WSB(WS_RG), WSB(WS_RG), u >> 9, (u >> 3) & 63, u & 7, ln); }
    xcd_barrier(bar);
    {
        pg8::EpiArgs e{}; e.O = WSB(WS_YSB); e.ldc = 1024; e.scale0 = 1.f;
        run_gemm<pg8::EPI_PLAIN>(lds, WSB(WS_SBQ), WSB(W_SBO), TOK, 1024, 512, e);
        e = pg8::EpiArgs{}; e.O = WSB(WS_YRET); e.ldc = 1024; e.scale0 = 1.f;
        run_gemm<pg8::EPI_PLAIN>(lds, WSB(WS_RG), WSB(W_RETO), TOK, 1024, D, e);
    }
    xcd_barrier(bar);
    {
        pg8::EpiArgs e{}; e.O = WSB(WS_MIXIN); e.ldc = 1024; e.f0 = args.in[3]; e.h0 = WSB(WS_YSB); e.h1 = WSB(WS_YRET);
        run_gemm<pg8::EPI_GATEMIX>(lds, XB, WSB(W_GATE), TOK, 2048, D, e);
    }
    xcd_barrier(bar);
    {
        pg8::EpiArgs e{}; e.f0 = args.in[0]; e.Of = args.out;
        run_gemm<pg8::EPI_RES>(lds, WSB(WS_MIXIN), WSB(W_MIXO), TOK, 1024, D, e);
    }
    xcd_barrier(bar);
    { FRESH_LANE(); ln_pass(args.out, args.in[7], args.in[8], XB, gw, NGW, ln); }
    xcd_barrier(bar);
    {
        pg8::EpiArgs e{}; e.O = WSB(WS_QM); e.ldc = 1024; e.scale0 = 1.f;
        run_gemm<pg8::EPI_PLAIN>(lds, XB, WSB(W_MEMQ), TOK, 1024, D, e);
    }
    xcd_barrier(bar);
    { FRESH_LANE(); for (int u = gw; u < BATCH * 4 * (SEQ / 16); u += NGW) xattn_unit(WSB(WS_QM), WSB(WS_MEMK), WSB(WS_MEMVT), WSB(WS_QM), u >> 11, (u >> 9) & 3, u & 511, ln); }
    xcd_barrier(bar);
    {
        pg8::EpiArgs e{}; e.f0 = args.out; e.Of = args.out;
        run_gemm<pg8::EPI_RES>(lds, WSB(WS_QM), WSB(W_MEMO), TOK, 1024, D, e);
    }
    xcd_barrier(bar);
    { FRESH_LANE(); ln_pass(args.out, args.in[12], args.in[13], XB, gw, NGW, ln); }
    xcd_barrier(bar);
    {
        pg8::EpiArgs e{}; e.O = WSB(WS_HID); e.ldc = FFH;
        run_gemm<pg8::EPI_SWIGLU>(lds, XB, WSB(W_FFNI), TOK, 2 * FFH, D, e);
    }
    xcd_barrier(bar);
    {
        pg8::EpiArgs e{}; e.f0 = args.out; e.Of = args.out;
        run_gemm<pg8::EPI_RES>(lds, WSB(WS_HID), WSB(W_FFNO), TOK, 1024, FFH, e);
    }
    xcd_barrier(bar);
    { FRESH_LANE(); ln_pass(args.out, args.in[16], args.in[17], nullptr, gw, NGW, ln); }
#undef WSB
}

extern "C" void kernel_launch(void* const* d_in, const int* in_sizes, int n_in, void* d_out, int out_size, void* d_ws, size_t ws_size, hipStream_t stream) {
    static int grid = 0;
    if (grid == 0) {
        if (n_in != 18 || out_size != TOK * D || ws_size < WS_END) { fprintf(stderr, "kernel_launch: unexpected problem shape (n_in %d out %d ws %zu)\n", n_in, out_size, ws_size); grid = -1; return; }
        int dev = 0, cus = 0, per_cu = 0;
        hipGetDevice(&dev); hipDeviceGetAttribute(&cus, hipDeviceAttributeMultiprocessorCount, dev);
        hipFuncSetAttribute((const void*)mega_fwd, hipFuncAttributeMaxDynamicSharedMemorySize, LDS_BYTES);
        hipOccupancyMaxActiveBlocksPerMultiprocessor(&per_cu, (const void*)mega_fwd, NWAVES * 64, LDS_BYTES);
        if (per_cu < 1) { fprintf(stderr, "kernel_launch: occupancy query says %d blocks per CU\n", per_cu); per_cu = 1; }
        grid = cus;
        (void)hipGetLastError();
    }
    if (grid < 0) return;
    Args a{};
    for (int i = 0; i < 18; ++i) a.in[i] = (const float*)d_in[i];
    a.out = (float*)d_out; a.ws = (unsigned char*)d_ws;
    if (hipMemsetAsync(d_ws, 0, 65536, stream) != hipSuccess) { fprintf(stderr, "kernel_launch: hipMemsetAsync failed\n"); return; }
    void* kargs[] = {&a};
    hipError_t e = hipLaunchCooperativeKernel((const void*)mega_fwd, dim3(grid), dim3(NWAVES * 64), kargs, LDS_BYTES, stream);
    if (e != hipSuccess) fprintf(stderr, "cooperative launch failed: %s (grid %d)\n", hipGetErrorString(e), grid);
}
```
